# Optimizing an MI355X kernel written in HIP

```python
import math
import jax
import jax.numpy as jnp
from jax import lax
import numpy as np

D_MODEL = 1024
BATCH = 2
SEQ = 8192
DEPTH = 2

N_HEADS = 8
HEAD_DIM = D_MODEL // (2 * N_HEADS)
V_DIM = 2 * HEAD_DIM
QK_WIDTH = N_HEADS * 2 * HEAD_DIM
ATTN_WIDTH = N_HEADS * V_DIM
RNN_WIDTH = D_MODEL
RNN_BLOCKS = 8
RNN_BLOCK = RNN_WIDTH // RNN_BLOCKS
RNN_CONV = 4
RGLRU_C = 8.0
D_FF = 3 * D_MODEL
FFN_CONV = 3
ROPE_THETA = 10000.0
Q_BLOCK = 128
EPS = 1e-6
N_MOD = 6
IN_WIDTH = 2 * QK_WIDTH + ATTN_WIDTH + 2 * RNN_WIDTH + 2 * D_MODEL

kernel_name = 'hybrid_rglru_diffattn_convffn_adaln'


def rms_norm(x, g):
    xf = x.astype(jnp.float32)
    y = xf * lax.rsqrt(jnp.mean(xf * xf, axis=-1, keepdims=True) + EPS)
    return (y * g.astype(jnp.float32)).astype(x.dtype)


def rope_tables(positions):
    inv_freq = ROPE_THETA ** (-jnp.arange(0, HEAD_DIM, 2, dtype=jnp.float32) / HEAD_DIM)
    ang = positions.astype(jnp.float32)[..., None] * inv_freq
    return jnp.cos(ang), jnp.sin(ang)


def apply_rope(t, cos, sin):
    tf = t.astype(jnp.float32)
    t1, t2 = jnp.split(tf, 2, axis=-1)
    cb = cos[:, :, None, None, :]
    sb = sin[:, :, None, None, :]
    return jnp.concatenate([t1 * cb - t2 * sb, t2 * cb + t1 * sb], axis=-1).astype(t.dtype)


def causal_dwconv(x, w, b):
    width = w.shape[0]
    s = x.shape[1]
    xp = jnp.pad(x, ((0, 0), (width - 1, 0), (0, 0)))
    y = b
    for j in range(width):
        y = y + xp[:, j:j + s, :] * w[j]
    return y


def rg_lru(x, w_a, b_a, w_i, b_i, lam):
    bsz, s, width = x.shape
    xf = x.astype(jnp.float32)
    xb = xf.reshape(bsz, s, RNN_BLOCKS, RNN_BLOCK)
    r = jax.nn.sigmoid(jnp.einsum('bsnk,nkj->bsnj', xb, w_a.astype(jnp.float32)).reshape(bsz, s, width)
                       + b_a.astype(jnp.float32))
    i = jax.nn.sigmoid(jnp.einsum('bsnk,nkj->bsnj', xb, w_i.astype(jnp.float32)).reshape(bsz, s, width)
                       + b_i.astype(jnp.float32))
    log_a = -RGLRU_C * r * jax.nn.softplus(-lam.astype(jnp.float32))
    a = jnp.exp(log_a)
    u = jnp.sqrt(-jnp.expm1(2.0 * log_a)) * (i * xf)

    def combine(lhs, rhs):
        a_l, h_l = lhs
        a_r, h_r = rhs
        return a_l * a_r, a_r * h_l + h_r

    _, h = lax.associative_scan(combine, (a, u), axis=1)
    return h.astype(x.dtype)


def diff_attention(q, k, v, lam, g_subln, out_scale):
    bsz, s, n_h, _, d_h = q.shape
    n_blk = s // Q_BLOCK
    qb = (q * (d_h ** -0.5)).reshape(bsz, n_blk, Q_BLOCK, n_h, 2, d_h)
    qb = jnp.moveaxis(qb, 1, 0)
    key_pos = jnp.arange(s)

    def one_block(args):
        q_blk, blk = args
        scores = jnp.einsum('bqhcd,bkhcd->bhcqk', q_blk, k, preferred_element_type=jnp.float32)
        query_pos = blk * Q_BLOCK + jnp.arange(Q_BLOCK)
        causal = key_pos[None, :] <= query_pos[:, None]
        scores = jnp.where(causal, scores, -jnp.inf)
        probs = jax.nn.softmax(scores, axis=-1)
        weights = probs[:, :, 0] - lam * probs[:, :, 1]
        return jnp.einsum('bhqk,bkhd->bqhd', weights.astype(v.dtype), v)

    o = lax.map(one_block, (qb, jnp.arange(n_blk)))
    o = jnp.moveaxis(o, 0, 1).reshape(bsz, s, n_h, V_DIM)
    o = rms_norm(o, g_subln) * out_scale
    return o.reshape(bsz, s, n_h * V_DIM)


def setup_inputs(seed: int = 0) -> dict:
    key = jax.random.key(seed)
    ks = jax.random.split(key, 26)

    def nrm(k, shape, scale):
        return jax.random.normal(k, shape, jnp.float32) * scale

    x = nrm(ks[0], (BATCH, SEQ, D_MODEL), 1.0)
    c = nrm(ks[1], (BATCH, D_MODEL), 1.0)
    positions = (jnp.arange(SEQ, dtype=jnp.int32)[None, :]
                 + jax.random.randint(ks[2], (BATCH, 1), 0, 1024, dtype=jnp.int32))
    w_mod = nrm(ks[3], (DEPTH, D_MODEL, N_MOD * D_MODEL), 0.5 * D_MODEL ** -0.5)
    b_mod = nrm(ks[4], (DEPTH, N_MOD * D_MODEL), 0.01)
    g_norm_mix = 1.0 + nrm(ks[5], (DEPTH, D_MODEL), 0.02)
    w_in = nrm(ks[6], (DEPTH, D_MODEL, IN_WIDTH), D_MODEL ** -0.5)
    lam_q1 = nrm(ks[7], (DEPTH, HEAD_DIM), 0.1)
    lam_k1 = nrm(ks[8], (DEPTH, HEAD_DIM), 0.1)
    lam_q2 = nrm(ks[9], (DEPTH, HEAD_DIM), 0.1)
    lam_k2 = nrm(ks[10], (DEPTH, HEAD_DIM), 0.1)
    g_subln = 1.0 + nrm(ks[11], (DEPTH, V_DIM), 0.02)
    conv_rnn_w = nrm(ks[12], (DEPTH, RNN_CONV, RNN_WIDTH), RNN_CONV ** -0.5)
    conv_rnn_b = nrm(ks[13], (DEPTH, RNN_WIDTH), 0.01)
    w_rg_a = nrm(ks[14], (DEPTH, RNN_BLOCKS, RNN_BLOCK, RNN_BLOCK), RNN_BLOCK ** -0.5)
    b_rg_a = nrm(ks[15], (DEPTH, RNN_WIDTH), 0.01)
    w_rg_i = nrm(ks[16], (DEPTH, RNN_BLOCKS, RNN_BLOCK, RNN_BLOCK), RNN_BLOCK ** -0.5)
    b_rg_i = nrm(ks[17], (DEPTH, RNN_WIDTH), 0.01)
    a_target = jax.random.uniform(ks[18], (DEPTH, RNN_WIDTH), jnp.float32, 0.9, 0.999)
    base = a_target ** (1.0 / RGLRU_C)
    lam_rg = jnp.log(base) - jnp.log1p(-base)
    w_out = nrm(ks[19], (DEPTH, D_MODEL, D_MODEL), D_MODEL ** -0.5)
    g_norm_ffn = 1.0 + nrm(ks[20], (DEPTH, D_MODEL), 0.02)
    w_up = nrm(ks[21], (DEPTH, D_MODEL, 2 * D_FF), D_MODEL ** -0.5)
    conv_ffn_w = nrm(ks[22], (DEPTH, FFN_CONV, 2 * D_FF), FFN_CONV ** -0.5)
    conv_ffn_b = nrm(ks[23], (DEPTH, 2 * D_FF), 0.01)
    w_down = nrm(ks[24], (DEPTH, D_FF, D_MODEL), D_FF ** -0.5)
    g_final = 1.0 + nrm(ks[25], (D_MODEL,), 0.02)
    return {'x': x, 'c': c, 'positions': positions, 'w_mod': w_mod, 'b_mod': b_mod,
            'g_norm_mix': g_norm_mix, 'w_in': w_in, 'lam_q1': lam_q1, 'lam_k1': lam_k1,
            'lam_q2': lam_q2, 'lam_k2': lam_k2, 'g_subln': g_subln,
            'conv_rnn_w': conv_rnn_w, 'conv_rnn_b': conv_rnn_b, 'w_rg_a': w_rg_a,
            'b_rg_a': b_rg_a, 'w_rg_i': w_rg_i, 'b_rg_i': b_rg_i, 'lam_rg': lam_rg,
            'w_out': w_out, 'g_norm_ffn': g_norm_ffn, 'w_up': w_up,
            'conv_ffn_w': conv_ffn_w, 'conv_ffn_b': conv_ffn_b, 'w_down': w_down,
            'g_final': g_final}


def reference(x, c, positions, w_mod, b_mod, g_norm_mix, w_in, lam_q1, lam_k1, lam_q2, lam_k2,
              g_subln, conv_rnn_w, conv_rnn_b, w_rg_a, b_rg_a, w_rg_i, b_rg_i, lam_rg,
              w_out, g_norm_ffn, w_up, conv_ffn_w, conv_ffn_b, w_down, g_final):
    bsz, s, _ = x.shape
    cos, sin = rope_tables(positions)
    c_act = jax.nn.silu(c)
    splits = [QK_WIDTH, 2 * QK_WIDTH, 2 * QK_WIDTH + ATTN_WIDTH,
              2 * QK_WIDTH + ATTN_WIDTH + RNN_WIDTH,
              2 * QK_WIDTH + ATTN_WIDTH + 2 * RNN_WIDTH,
              2 * QK_WIDTH + ATTN_WIDTH + 2 * RNN_WIDTH + D_MODEL]
    for l in range(DEPTH):
        lam_init = 0.8 - 0.6 * math.exp(-0.3 * l)
        mod = c_act @ w_mod[l] + b_mod[l]
        sh1, sc1, gt1, sh2, sc2, gt2 = [m[:, None, :] for m in jnp.split(mod, N_MOD, axis=-1)]

        h = rms_norm(x, g_norm_mix[l]) * (1.0 + sc1) + sh1
        proj = h @ w_in[l]
        q, k, v, xr, yr, ga, gr = jnp.split(proj, splits, axis=-1)
        q = apply_rope(q.reshape(bsz, s, N_HEADS, 2, HEAD_DIM), cos, sin)
        k = apply_rope(k.reshape(bsz, s, N_HEADS, 2, HEAD_DIM), cos, sin)
        v = v.reshape(bsz, s, N_HEADS, V_DIM)
        lam = (jnp.exp(jnp.sum(lam_q1[l] * lam_k1[l]).astype(jnp.float32))
               - jnp.exp(jnp.sum(lam_q2[l] * lam_k2[l]).astype(jnp.float32)) + lam_init)
        o_attn = diff_attention(q, k, v, lam, g_subln[l], 1.0 - lam_init)

        xr = causal_dwconv(xr, conv_rnn_w[l], conv_rnn_b[l])
        o_rnn = rg_lru(xr, w_rg_a[l], b_rg_a[l], w_rg_i[l], b_rg_i[l], lam_rg[l]) * jax.nn.gelu(yr)

        mixed = jax.nn.sigmoid(ga) * o_attn + jax.nn.sigmoid(gr) * o_rnn
        x = x + gt1 * (mixed @ w_out[l])

        h = rms_norm(x, g_norm_ffn[l]) * (1.0 + sc2) + sh2
        u = causal_dwconv(h @ w_up[l], conv_ffn_w[l], conv_ffn_b[l])
        val, gate = jnp.split(u, 2, axis=-1)
        x = x + gt2 * ((jax.nn.gelu(gate) * val) @ w_down[l])
    return rms_norm(x, g_final)
```

```cpp
#include <hip/hip_runtime.h>
#include <stdint.h>

typedef unsigned short bf16_t;
constexpr int NB = 2, SEQ = 8192, DM = 1024, M = NB * SEQ, NIN = 7168, DFF = 3072, NUP = 6144;
constexpr float EPS = 1e-6f;
constexpr float C2 = 0.125f * 1.4426950408889634f;

__device__ __forceinline__ float bf2f(bf16_t v) { return __uint_as_float(((unsigned)v) << 16); }
__device__ __forceinline__ bf16_t f2bf(float f) { unsigned u = __float_as_uint(f); return (bf16_t)((u + 0x7fffu + ((u >> 16) & 1u)) >> 16); }
__device__ __forceinline__ float sigmoidf_(float x) { return 1.f / (1.f + __expf(-x)); }
__device__ __forceinline__ float gelu_tanh(float x) { const float u = 0.7978845608028654f * (x + 0.044715f * x * x * x); return 0.5f * x * (1.f + tanhf(u)); }
__device__ __forceinline__ float wave_sum(float v) {
#pragma unroll
    for (int o = 1; o < 64; o <<= 1) v += __shfl_xor(v, o);
    return v;
}

constexpr size_t MiB = 1u << 20;
constexpr size_t SLOT = 32 * MiB;
constexpr size_t OFF_MOD = 64 * 1024;
constexpr size_t OFF_LAM = 192 * 1024;
constexpr size_t OFF_COS = 256 * 1024;
constexpr size_t OFF_SIN = OFF_COS + 2 * MiB;

__global__ void __launch_bounds__(256) k_mod(const float* __restrict__ c, const float* __restrict__ w_mod, const float* __restrict__ b_mod,
                                             const float* lq1, const float* lk1, const float* lq2, const float* lk2, float* mod, float* lam) {
    const int idx = blockIdx.x * 256 + threadIdx.x;
    if (idx < 2 * 2 * 6144) {
        const int n = idx % 6144, b = (idx / 6144) % 2, l = idx / (2 * 6144);
        const float* w = w_mod + (size_t)l * 1024 * 6144 + n;
        float acc = b_mod[l * 6144 + n];
        for (int k = 0; k < 1024; ++k) { const float cv = c[b * 1024 + k]; acc += (cv / (1.f + __expf(-cv))) * w[(size_t)k * 6144]; }
        mod[idx] = acc;
    }
    if (blockIdx.x == 0 && threadIdx.x < 2) {
        const int l = threadIdx.x; float s1 = 0.f, s2 = 0.f;
        for (int i = 0; i < 64; ++i) { s1 += lq1[l * 64 + i] * lk1[l * 64 + i]; s2 += lq2[l * 64 + i] * lk2[l * 64 + i]; }
        const float lam_init = 0.8f - 0.6f * expf(-0.3f * (float)l);
        lam[l] = expf(s1) - expf(s2) + lam_init;
    }
}

__global__ void __launch_bounds__(256) k_rope(const int* __restrict__ pos, float* cs, float* sn) {
    const int idx = blockIdx.x * 256 + threadIdx.x;
    if (idx >= M * 32) return;
    const int row = idx >> 5, i = idx & 31;
    const float inv = (float)exp(-(double)i * (log(10000.0) / 32.0));
    const float ang = (float)pos[row] * inv;
    const double a = (double)ang;
    const double k = rint(a * 0.15915494309189535);
    const double r = fma(-k, 6.283185307179586, a) - k * 2.4492935982947064e-16;
    const float rf = (float)r;
    cs[idx] = __cosf(rf); sn[idx] = __sinf(rf);
}

__global__ void __launch_bounds__(256) k_prep_a(const float* __restrict__ x, const float* __restrict__ g, const float* __restrict__ sh, const float* __restrict__ sc, bf16_t* xa) {
    const int row = blockIdx.x * 4 + (threadIdx.x >> 6), lane = threadIdx.x & 63, b = row / SEQ;
    const float4* xr = (const float4*)(x + (size_t)row * DM);
    float4 v[4]; float s = 0.f;
#pragma unroll
    for (int j = 0; j < 4; ++j) { v[j] = xr[lane + 64 * j]; s += v[j].x * v[j].x + v[j].y * v[j].y + v[j].z * v[j].z + v[j].w * v[j].w; }
    const float rstd = rsqrtf(wave_sum(s) * (1.f / DM) + EPS);
#pragma unroll
    for (int j = 0; j < 4; ++j) {
        const int k = (lane + 64 * j) * 4;
        const float4 gg = *(const float4*)(g + k), s1 = *(const float4*)(sc + b * 6144 + k), h1 = *(const float4*)(sh + b * 6144 + k);
        ushort4 o;
        o.x = f2bf(v[j].x * rstd * gg.x * (1.f + s1.x) + h1.x); o.y = f2bf(v[j].y * rstd * gg.y * (1.f + s1.y) + h1.y);
        o.z = f2bf(v[j].z * rstd * gg.z * (1.f + s1.z) + h1.z); o.w = f2bf(v[j].w * rstd * gg.w * (1.f + s1.w) + h1.w);
        *(ushort4*)(xa + (size_t)row * DM + k) = o;
    }
}

template <class Cfg> __global__ void __launch_bounds__(256) k_gemm(const bf16_t* __restrict__ A, const float* __restrict__ W, int K, int ldw, Cfg cfg) {
    __shared__ float As[16][68];
    __shared__ float Bs[16][64];
    const int t = threadIdx.x, ty = t >> 4, tx = t & 15, tile_n = blockIdx.x, row_base = blockIdx.y * 64;
    float acc[4][4];
#pragma unroll
    for (int i = 0; i < 4; ++i)
#pragma unroll
        for (int j = 0; j < 4; ++j) acc[i][j] = 0.f;
    const int ar = t >> 2, ak = (t & 3) * 4;
    const int bk = t >> 4;
    int bcol[4];
#pragma unroll
    for (int j = 0; j < 4; ++j) bcol[j] = cfg.col(tile_n, j) + tx;
    for (int k0 = 0; k0 < K; k0 += 16) {
        const ushort4 av = *(const ushort4*)(A + (size_t)(row_base + ar) * K + k0 + ak);
        As[ak + 0][ar] = bf2f(av.x); As[ak + 1][ar] = bf2f(av.y); As[ak + 2][ar] = bf2f(av.z); As[ak + 3][ar] = bf2f(av.w);
#pragma unroll
        for (int j = 0; j < 4; ++j) Bs[bk][tx + 16 * j] = W[(size_t)(k0 + bk) * ldw + bcol[j]];
        __syncthreads();
#pragma unroll
        for (int kk = 0; kk < 16; ++kk) {
            const float4 a4 = *(const float4*)&As[kk][ty * 4];
            const float a[4] = {a4.x, a4.y, a4.z, a4.w};
            float bv[4];
#pragma unroll
            for (int j = 0; j < 4; ++j) bv[j] = Bs[kk][tx + 16 * j];
#pragma unroll
            for (int i = 0; i < 4; ++i)
#pragma unroll
                for (int j = 0; j < 4; ++j) acc[i][j] += a[i] * bv[j];
        }
        __syncthreads();
    }
    cfg.epi(row_base + ty * 4, tile_n, tx, acc);
}

struct CfgIn {
    bf16_t *q, *k, *v, *xr, *sga, *g2; const float *cs, *sn;
    __device__ int col(int tn, int j) const {
        if (tn < 64) return tn * 64 + 16 * j;
        if (tn < 96) { const int ch0 = (tn - 64) * 32; return (j < 2 ? 4096 : 6144) + ch0 + 16 * (j & 1); }
        return 5120 + (tn - 96) * 64 + 16 * j;
    }
    __device__ void epi(int row0, int tn, int tx, const float (&acc)[4][4]) const {
#pragma unroll
        for (int i = 0; i < 4; ++i) {
            const int row = row0 + i;
            if (tn < 32) {
                bf16_t* dst = (tn < 16 ? q : k) + (size_t)row * DM + (tn & 15) * 64;
                const float scl = tn < 16 ? C2 : 1.f;
#pragma unroll
                for (int j = 0; j < 2; ++j) {
                    const int d = tx + 16 * j; const float cv = cs[row * 32 + d], sv = sn[row * 32 + d];
                    const float t1 = acc[i][j], t2 = acc[i][j + 2];
                    dst[d] = f2bf((t1 * cv - t2 * sv) * scl); dst[d + 32] = f2bf((t2 * cv + t1 * sv) * scl);
                }
            } else if (tn < 64) {
                bf16_t* dst = (tn < 48 ? v : xr) + (size_t)row * DM + (tn & 15) * 64;
#pragma unroll
                for (int j = 0; j < 4; ++j) dst[tx + 16 * j] = f2bf(acc[i][j]);
            } else if (tn < 96) {
                bf16_t* dst = g2 + (size_t)row * DM + (tn - 64) * 32;
#pragma unroll
                for (int j = 0; j < 2; ++j) dst[tx + 16 * j] = f2bf(sigmoidf_(acc[i][j + 2]) * gelu_tanh(acc[i][j]));
            } else {
                bf16_t* dst = sga + (size_t)row * DM + (tn - 96) * 64;
#pragma unroll
                for (int j = 0; j < 4; ++j) dst[tx + 16 * j] = f2bf(sigmoidf_(acc[i][j]));
            }
        }
    }
};
struct CfgRes {
    const float* xin; float* xout; const float* gt;
    __device__ int col(int tn, int j) const { return tn * 64 + 16 * j; }
    __device__ void epi(int row0, int tn, int tx, const float (&acc)[4][4]) const {
#pragma unroll
        for (int i = 0; i < 4; ++i) { const int row = row0 + i, b = row / SEQ;
#pragma unroll
            for (int j = 0; j < 4; ++j) { const int c = tn * 64 + tx + 16 * j; xout[(size_t)row * DM + c] = xin[(size_t)row * DM + c] + gt[b * 6144 + c] * acc[i][j]; } }
    }
};
struct CfgUp {
    bf16_t* u;
    __device__ int col(int tn, int j) const { return tn * 64 + 16 * j; }
    __device__ void epi(int row0, int tn, int tx, const float (&acc)[4][4]) const {
#pragma unroll
        for (int i = 0; i < 4; ++i)
#pragma unroll
            for (int j = 0; j < 4; ++j) u[(size_t)(row0 + i) * NUP + tn * 64 + tx + 16 * j] = f2bf(acc[i][j]);
    }
};

__global__ void __launch_bounds__(256) k_attn(const bf16_t* __restrict__ Q, const bf16_t* __restrict__ K, const bf16_t* __restrict__ V, bf16_t* O, const float* lamp) {
    __shared__ float Ks[64][64];
    __shared__ float Vs[64][128];
    const int t = blockIdx.x * 256 + threadIdx.x, h = blockIdx.y, b = blockIdx.z;
    const size_t rowb = (size_t)b * SEQ;
    const float lam = lamp[0];
    const int ntiles = (blockIdx.x * 256 + 256) / 64;
    for (int c = 0; c < 2; ++c) {
        const int hm = 2 * h + c;
        float q[64];
#pragma unroll
        for (int d = 0; d < 64; d += 4) { const ushort4 u = *(const ushort4*)(Q + (rowb + t) * DM + hm * 64 + d); q[d] = bf2f(u.x); q[d + 1] = bf2f(u.y); q[d + 2] = bf2f(u.z); q[d + 3] = bf2f(u.w); }
        float acc[128];
#pragma unroll
        for (int d = 0; d < 128; ++d) acc[d] = 0.f;
        float m = -1e30f, l = 0.f;
        for (int kt = 0; kt < ntiles; ++kt) {
            __syncthreads();
            for (int e = threadIdx.x; e < 64 * 16; e += 256) { const int key = e >> 4, d4 = (e & 15) * 4; const ushort4 u = *(const ushort4*)(K + (rowb + kt * 64 + key) * DM + hm * 64 + d4);
                Ks[key][d4] = bf2f(u.x); Ks[key][d4 + 1] = bf2f(u.y); Ks[key][d4 + 2] = bf2f(u.z); Ks[key][d4 + 3] = bf2f(u.w); }
            for (int e = threadIdx.x; e < 64 * 32; e += 256) { const int key = e >> 5, d4 = (e & 31) * 4; const ushort4 u = *(const ushort4*)(V + (rowb + kt * 64 + key) * DM + h * 128 + d4);
                Vs[key][d4] = bf2f(u.x); Vs[key][d4 + 1] = bf2f(u.y); Vs[key][d4 + 2] = bf2f(u.z); Vs[key][d4 + 3] = bf2f(u.w); }
            __syncthreads();
            for (int key = 0; key < 64; ++key) {
                if (kt * 64 + key <= t) {
                    float s = 0.f;
#pragma unroll
                    for (int d = 0; d < 64; d += 4) { const float4 kv = *(const float4*)&Ks[key][d]; s += q[d] * kv.x + q[d + 1] * kv.y + q[d + 2] * kv.z + q[d + 3] * kv.w; }
                    if (s > m) { const float f = exp2f(m - s); l *= f;
#pragma unroll
                        for (int d = 0; d < 128; ++d) acc[d] *= f;
                        m = s; }
                    const float p = exp2f(s - m); l += p;
#pragma unroll
                    for (int d = 0; d < 128; d += 4) { const float4 vv = *(const float4*)&Vs[key][d]; acc[d] += p * vv.x; acc[d + 1] += p * vv.y; acc[d + 2] += p * vv.z; acc[d + 3] += p * vv.w; }
                }
            }
        }
        const float il = 1.f / l;
        bf16_t* op = O + (rowb + t) * DM + h * 128;
        if (c == 0) {
#pragma unroll
            for (int d = 0; d < 128; ++d) op[d] = f2bf(acc[d] * il);
        } else {
#pragma unroll
            for (int d = 0; d < 128; ++d) op[d] = f2bf(bf2f(op[d]) - lam * acc[d] * il);
        }
        __threadfence_block();
    }
}

__global__ void __launch_bounds__(256) k_rnn(bf16_t* xr, const float* __restrict__ cw, const float* __restrict__ cb, const float* __restrict__ wa, const float* __restrict__ ba,
                                             const float* __restrict__ wi, const float* __restrict__ bi, const float* __restrict__ lamr) {
    __shared__ float xc_s[128];
    __shared__ float ri_s[2][128];
    const int n = blockIdx.x, b = blockIdx.y, g = threadIdx.x >> 7, j = threadIdx.x & 127, ch = n * 128 + j;
    float w[128];
    { const float* wp = (g == 0 ? wa : wi) + (size_t)n * 128 * 128 + j;
#pragma unroll
      for (int k = 0; k < 128; ++k) w[k] = wp[k * 128]; }
    const float bias = (g == 0 ? ba : bi)[ch];
    const float w0 = cw[ch], w1 = cw[1024 + ch], w2 = cw[2048 + ch], w3 = cw[3072 + ch], cbv = cb[ch];
    const float lr = lamr[ch]; const float sp = (lr > 0.f ? 0.f : -lr) + log1pf(expf(-fabsf(lr)));
    float x1 = 0.f, x2 = 0.f, x3 = 0.f, h = 0.f;
    bf16_t* col = xr + (size_t)b * SEQ * DM + ch;
    for (int t0 = 0; t0 < SEQ; t0 += 8) {
        float xn[8];
        if (g == 0) {
#pragma unroll
            for (int e = 0; e < 8; ++e) xn[e] = bf2f(col[(size_t)(t0 + e) * DM]);
        }
#pragma unroll
        for (int e = 0; e < 8; ++e) {
            float xcv = 0.f;
            if (g == 0) { xcv = cbv + w0 * x3 + w1 * x2 + w2 * x1 + w3 * xn[e]; x3 = x2; x2 = x1; x1 = xn[e]; xc_s[j] = xcv; }
            __syncthreads();
            float dot = 0.f;
#pragma unroll
            for (int k = 0; k < 128; k += 4) { const float4 xv = *(const float4*)&xc_s[k]; dot += xv.x * w[k] + xv.y * w[k + 1] + xv.z * w[k + 2] + xv.w * w[k + 3]; }
            ri_s[g][j] = sigmoidf_(dot + bias);
            __syncthreads();
            if (g == 0) {
                const float r = ri_s[0][j], ig = ri_s[1][j];
                const float log_a = -8.f * r * sp, a = __expf(log_a);
                const float u = sqrtf(-expm1f(2.f * log_a)) * (ig * xcv);
                h = a * h + u;
                col[(size_t)(t0 + e) * DM] = f2bf(h);
            }
        }
    }
}

__global__ void __launch_bounds__(256) k_mix(const bf16_t* __restrict__ O, const bf16_t* __restrict__ sga, const bf16_t* __restrict__ g2, const bf16_t* __restrict__ hr,
                                             const float* __restrict__ gs, float out_scale, bf16_t* mixed) {
    const int wv = blockIdx.x * 4 + (threadIdx.x >> 6), lane = threadIdx.x & 63, row = wv >> 3, h = wv & 7;
    const size_t off = (size_t)row * DM + h * 128 + lane * 2;
    const ushort2 ov = *(const ushort2*)(O + off);
    const float o0 = bf2f(ov.x), o1 = bf2f(ov.y);
    const float rn = rsqrtf(wave_sum(o0 * o0 + o1 * o1) * (1.f / 128.f) + EPS);
    const ushort2 a = *(const ushort2*)(sga + off), g = *(const ushort2*)(g2 + off), hh = *(const ushort2*)(hr + off);
    ushort2 r;
    r.x = f2bf(bf2f(a.x) * (o0 * rn * gs[lane * 2] * out_scale) + bf2f(g.x) * bf2f(hh.x));
    r.y = f2bf(bf2f(a.y) * (o1 * rn * gs[lane * 2 + 1] * out_scale) + bf2f(g.y) * bf2f(hh.y));
    *(ushort2*)(mixed + off) = r;
}

__global__ void __launch_bounds__(256) k_act(const bf16_t* __restrict__ u, const float* __restrict__ cw, const float* __restrict__ cb, bf16_t* act, int b) {
    const size_t idx = (size_t)blockIdx.x * 256 + threadIdx.x;
    const int ch = (int)(idx % DFF), t = (int)(idx / DFF);
    float val = cb[ch], gate = cb[DFF + ch];
#pragma unroll
    for (int j = 0; j < 3; ++j) { const int ts = t - 2 + j; if (ts >= 0) { val += cw[j * NUP + ch] * bf2f(u[(size_t)ts * NUP + ch]); gate += cw[j * NUP + DFF + ch] * bf2f(u[(size_t)ts * NUP + DFF + ch]); } }
    act[((size_t)b * SEQ + t) * DFF + ch] = f2bf(gelu_tanh(gate) * val);
}

__global__ void __launch_bounds__(256) k_final(float* x, const float* __restrict__ g) {
    const int row = blockIdx.x * 4 + (threadIdx.x >> 6), lane = threadIdx.x & 63;
    float4* xr = (float4*)(x + (size_t)row * DM);
    float4 v[4]; float s = 0.f;
#pragma unroll
    for (int j = 0; j < 4; ++j) { v[j] = xr[lane + 64 * j]; s += v[j].x * v[j].x + v[j].y * v[j].y + v[j].z * v[j].z + v[j].w * v[j].w; }
    const float rstd = rsqrtf(wave_sum(s) * (1.f / DM) + EPS);
#pragma unroll
    for (int j = 0; j < 4; ++j) { const float4 gg = *(const float4*)(g + (lane + 64 * j) * 4); float4 o; o.x = v[j].x * rstd * gg.x; o.y = v[j].y * rstd * gg.y; o.z = v[j].z * rstd * gg.z; o.w = v[j].w * rstd * gg.w; xr[lane + 64 * j] = o; }
}

extern "C" void kernel_launch(void* const* d_in, const int* in_sizes, int n_in, void* d_out, int out_size, void* d_ws, size_t ws_size, hipStream_t stream) {
    const float* x = (const float*)d_in[0]; const float* c = (const float*)d_in[1]; const int* pos = (const int*)d_in[2];
    const float* w_mod = (const float*)d_in[3]; const float* b_mod = (const float*)d_in[4]; const float* g_mix = (const float*)d_in[5];
    const float* w_in = (const float*)d_in[6];
    const float* g_subln = (const float*)d_in[11]; const float* conv_rnn_w = (const float*)d_in[12]; const float* conv_rnn_b = (const float*)d_in[13];
    const float* w_rg_a = (const float*)d_in[14]; const float* b_rg_a = (const float*)d_in[15]; const float* w_rg_i = (const float*)d_in[16]; const float* b_rg_i = (const float*)d_in[17];
    const float* lam_rg = (const float*)d_in[18]; const float* w_out = (const float*)d_in[19]; const float* g_ffn = (const float*)d_in[20]; const float* w_up = (const float*)d_in[21];
    const float* conv_ffn_w = (const float*)d_in[22]; const float* conv_ffn_b = (const float*)d_in[23]; const float* w_down = (const float*)d_in[24]; const float* g_final = (const float*)d_in[25];
    char* ws = (char*)d_ws; float* out = (float*)d_out;
    float* mod = (float*)(ws + OFF_MOD); float* lam = (float*)(ws + OFF_LAM); float* cs = (float*)(ws + OFF_COS); float* sn = (float*)(ws + OFF_SIN);
    bf16_t* S1 = (bf16_t*)(ws + 1 * SLOT); bf16_t* S2 = (bf16_t*)(ws + 2 * SLOT); bf16_t* S3 = (bf16_t*)(ws + 3 * SLOT); bf16_t* S4 = (bf16_t*)(ws + 4 * SLOT);
    bf16_t* S5 = (bf16_t*)(ws + 5 * SLOT); bf16_t* S6 = (bf16_t*)(ws + 6 * SLOT); bf16_t* S7 = (bf16_t*)(ws + 7 * SLOT);

    k_mod<<<96, 256, 0, stream>>>(c, w_mod, b_mod, (const float*)d_in[7], (const float*)d_in[8], (const float*)d_in[9], (const float*)d_in[10], mod, lam);
    k_rope<<<M * 32 / 256, 256, 0, stream>>>(pos, cs, sn);
    for (int l = 0; l < 2; ++l) {
        const float* xin = l == 0 ? x : out;
        const float* md = mod + (size_t)l * 2 * 6144;
        const float lam_init = 0.8f - 0.6f * expf(-0.3f * (float)l);
        k_prep_a<<<M / 4, 256, 0, stream>>>(xin, g_mix + l * DM, md + 0, md + 1024, S1);
        CfgIn ci{S2, S3, S4, S5, S6, S7, cs, sn};
        k_gemm<CfgIn><<<dim3(112, M / 64), 256, 0, stream>>>(S1, w_in + (size_t)l * DM * NIN, DM, NIN, ci);
        k_attn<<<dim3(SEQ / 256, 8, 2), 256, 0, stream>>>(S2, S3, S4, S1, lam + l);
        k_rnn<<<dim3(8, 2), 256, 0, stream>>>(S5, conv_rnn_w + (size_t)l * 4 * DM, conv_rnn_b + l * DM, w_rg_a + (size_t)l * 8 * 128 * 128, b_rg_a + l * DM,
                                              w_rg_i + (size_t)l * 8 * 128 * 128, b_rg_i + l * DM, lam_rg + l * DM);
        k_mix<<<M * 8 / 4, 256, 0, stream>>>(S1, S6, S7, S5, g_subln + l * 128, 1.f - lam_init, S2);
        CfgRes co{xin, out, md + 2048};
        k_gemm<CfgRes><<<dim3(16, M / 64), 256, 0, stream>>>(S2, w_out + (size_t)l * DM * DM, DM, DM, co);
        k_prep_a<<<M / 4, 256, 0, stream>>>(out, g_ffn + l * DM, md + 3072, md + 4096, S1);
        for (int b = 0; b < 2; ++b) {
            CfgUp cu{S2};
            k_gemm<CfgUp><<<dim3(96, SEQ / 64), 256, 0, stream>>>(S1 + (size_t)b * SEQ * DM, w_up + (size_t)l * DM * NUP, DM, NUP, cu);
            k_act<<<(unsigned)((size_t)SEQ * DFF / 256), 256, 0, stream>>>(S2, conv_ffn_w + (size_t)l * 3 * NUP, conv_ffn_b + l * NUP, S5, b);
        }
        CfgRes cd{out, out, md + 5120};
        k_gemm<CfgRes><<<dim3(16, M / 64), 256, 0, stream>>>(S5, w_down + (size_t)l * DFF * DM, DFF, DM, cd);
    }
    k_final<<<M / 4, 256, 0, stream>>>(out, g_final);
}
```

```cpp
#include <hip/hip_runtime.h>
#include <stdint.h>
#include <cstdio>
#include <cstdint>
#include <cstddef>

constexpr int NB = 2, SEQ = 8192, DM = 1024, M = NB * SEQ, NIN = 7168, DFF = 3072, NUP = 6144;
constexpr size_t MiB = 1u << 20;
constexpr size_t SLOT = 32 * MiB;

namespace pg8 {
#define PG8_LAS __attribute__((address_space(3)))
typedef unsigned short bf16_t;
typedef short bf16x8 __attribute__((ext_vector_type(8)));
typedef float f32x4 __attribute__((ext_vector_type(4)));
typedef unsigned u32x4 __attribute__((ext_vector_type(4)));
constexpr int BM = 256, BK = 64, HALF = 128, HTB = HALF * BK * 2  , STAGE_BYTES = 8 * HTB, NXCD = 8, WGM = 8;

__host__ __device__ __forceinline__ int lds_byte(int r, int c) { const int st = (r >> 4) * 2 + (c >> 5), rr = r & 15, cc = c & 31, ob = rr * 64 + cc * 2; return st * 1024 + (ob ^ (((ob >> 9) & 1) << 5)); }
__host__ __device__ __forceinline__ void stage_rc(int b, int& R, int& C) { const int st = b / 1024, sb = b % 1024, swz = sb ^ (((sb >> 9) & 1) << 5); R = (st >> 1) * 16 + swz / 64; C = (st & 1) * 32 + (swz % 64) / 2; }
__host__ __device__ __forceinline__ int perm32(int rho) { const int n = rho >> 4, i = rho & 15; return 8 * (i >> 2) + 4 * n + (i & 3); }

struct Unit { int pm, pn; };
struct Gemm { const bf16_t* A; const bf16_t* Bt; int M, N, K; };

struct StaticOrder {
    int nM, nN, nwg, G, c;
    __host__ __device__ void init(int M, int N, int G_, int c_) { nM = M / BM; nN = N / BM; nwg = nM * nN; G = G_; c = c_; }
    __host__ __device__ bool next(int i, Unit& u) const {
        const long L = (long)i * G + c; if (L >= nwg) return false;
        int wgid = (int)L; { const int q = nwg / NXCD, r = nwg % NXCD, xcd = wgid % NXCD, off = wgid / NXCD; wgid = (xcd < r ? xcd * (q + 1) : r * (q + 1) + (xcd - r) * q) + off; }
        const int nig = WGM * nN, gid = wgid / nig, fm = gid * WGM, gsz = (nM - fm) < WGM ? (nM - fm) : WGM;
        u.pm = fm + ((wgid % nig) % gsz); u.pn = (wgid % nig) / gsz; return true;
    }
    __device__ __forceinline__ void a_ready(const Unit&) const {}
    __device__ __forceinline__ void done(const Unit&) const {}
};

__device__ __forceinline__ unsigned cvt_pk_bf16(float lo, float hi) { unsigned r; asm volatile("v_cvt_pk_bf16_f32 %0, %1, %2" : "=v"(r) : "v"(lo), "v"(hi)); return r; }

typedef unsigned u32x2 __attribute__((ext_vector_type(2)));
__device__ __forceinline__ float fast_sigmoid(float x) { return __builtin_amdgcn_rcpf(1.0f + __expf(-x)); }
__device__ __forceinline__ float fast_gelu(float x) { const float u = 1.5957691216057308f * (x + 0.044715f * x * x * x); return x * __builtin_amdgcn_rcpf(1.0f + __expf(-u)); }
__device__ __forceinline__ float gelu_mul(float g, float v) { const float t = g * g, p = __builtin_fmaf(t, -2.3022081985f * 0.044715f, -2.3022081985f); return (g * v) * __builtin_amdgcn_rcpf(1.0f + __builtin_amdgcn_exp2f(p * g)); }
constexpr float EPS_ = 1e-6f;
constexpr float C2Q = 0.125f * 1.4426950408889634f;

struct EpiIn {
    static constexpr bool PERM = true, APERM = false, AFTER_DRAIN = false;
    bf16_t* slots; const float *cs, *sn, *rowss, *bias;
    __device__ __forceinline__ void operator()(const f32x4 (&acc)[2][2][4][2], const Unit& u, int wr, int wc, int fr_, int fq_) const {
        int fr = fr_, fq = fq_; asm volatile("" : "+v"(fr), "+v"(fq));
        const int b = u.pm >> 5, pn = u.pn, pbase = wc * 32 + 8 * fq;
        bf16_t* const dstb = slots + (size_t)(pn < 16 ? (pn >> 2) : (pn < 24 ? 5 : 4)) * ((size_t)16384 * 1024);
        f32x4 bv[2][2];
#pragma unroll
        for (int bj = 0; bj < 2; ++bj)
#pragma unroll
            for (int n = 0; n < 2; ++n) bv[bj][n] = *(const f32x4*)(bias + b * 7168 + pn * 256 + bj * 128 + pbase + 4 * n);
        float rsv[2][4];
#pragma unroll
        for (int ai = 0; ai < 2; ++ai)
#pragma unroll
            for (int m = 0; m < 4; ++m) rsv[ai][m] = rowss[u.pm * BM + ai * HALF + wr * 64 + m * 16 + fr];
#pragma unroll
        for (int ai = 0; ai < 2; ++ai)
#pragma unroll
            for (int m = 0; m < 4; ++m) {
                const int row = u.pm * BM + ai * HALF + wr * 64 + m * 16 + fr;
                const float rstd = __builtin_amdgcn_rsqf(rsv[ai][m] * (1.0f / 1024.0f) + EPS_);
                if (pn < 8) {
                    const float scl = pn < 4 ? C2Q : 1.0f;
                    bf16_t* base = dstb + (size_t)row * 1024 + (4 * (pn & 3) + wc) * 64 + 8 * fq;
                    f32x4 o1[2], o2[2];
#pragma unroll
                    for (int n = 0; n < 2; ++n) {
                        const f32x4 c4 = *(const f32x4*)(cs + (size_t)row * 32 + 8 * fq + 4 * n), s4 = *(const f32x4*)(sn + (size_t)row * 32 + 8 * fq + 4 * n);
                        const f32x4 t1 = acc[ai][0][m][n] * rstd + bv[0][n], t2 = acc[ai][1][m][n] * rstd + bv[1][n];
                        o1[n] = (t1 * c4 - t2 * s4) * scl; o2[n] = (t2 * c4 + t1 * s4) * scl;
                    }
                    u32x4 w1, w2;
                    w1.x = cvt_pk_bf16(o1[0][0], o1[0][1]); w1.y = cvt_pk_bf16(o1[0][2], o1[0][3]); w1.z = cvt_pk_bf16(o1[1][0], o1[1][1]); w1.w = cvt_pk_bf16(o1[1][2], o1[1][3]);
                    w2.x = cvt_pk_bf16(o2[0][0], o2[0][1]); w2.y = cvt_pk_bf16(o2[0][2], o2[0][3]); w2.z = cvt_pk_bf16(o2[1][0], o2[1][1]); w2.w = cvt_pk_bf16(o2[1][2], o2[1][3]);
                    *(u32x4*)base = w1; *(u32x4*)(base + 32) = w2;
                } else if (pn < 16 || pn >= 24) {
                    bf16_t* base = dstb + (size_t)row * 1024 + (pn & 3) * 256 + pbase;
#pragma unroll
                    for (int bj = 0; bj < 2; ++bj) {
                        f32x4 v0 = acc[ai][bj][m][0] * rstd + bv[bj][0], v1 = acc[ai][bj][m][1] * rstd + bv[bj][1];
                        if (pn >= 24) {
#pragma unroll
                            for (int e = 0; e < 4; ++e) { v0[e] = fast_sigmoid(v0[e]); v1[e] = fast_sigmoid(v1[e]); }
                        }
                        u32x4 w; w.x = cvt_pk_bf16(v0[0], v0[1]); w.y = cvt_pk_bf16(v0[2], v0[3]); w.z = cvt_pk_bf16(v1[0], v1[1]); w.w = cvt_pk_bf16(v1[2], v1[3]);
                        *(u32x4*)(base + bj * HALF) = w;
                    }
                } else {
                    bf16_t* base = dstb + (size_t)row * 1024 + (pn - 16) * 128 + pbase;
                    f32x4 o[2];
#pragma unroll
                    for (int n = 0; n < 2; ++n) {
                        const f32x4 yr = acc[ai][0][m][n] * rstd + bv[0][n], gr = acc[ai][1][m][n] * rstd + bv[1][n];
#pragma unroll
                        for (int e = 0; e < 4; ++e) o[n][e] = fast_sigmoid(gr[e]) * fast_gelu(yr[e]);
                    }
                    u32x4 w; w.x = cvt_pk_bf16(o[0][0], o[0][1]); w.y = cvt_pk_bf16(o[0][2], o[0][3]); w.z = cvt_pk_bf16(o[1][0], o[1][1]); w.w = cvt_pk_bf16(o[1][2], o[1][3]);
                    *(u32x4*)base = w;
                }
                if (m & 1) asm volatile("" ::: "memory");
            }
    }
};

struct EpiRes {
    static constexpr bool PERM = true, APERM = false, AFTER_DRAIN = false;
    const float* xin; float* xout; const float* gt; const float* gnext; const float* scnext; bf16_t* xa; float* rowss;
    __device__ __forceinline__ void operator()(const f32x4 (&acc)[2][2][4][2], const Unit& u, int wr, int wc, int fr_, int fq_) const {
        int fr = fr_, fq = fq_; asm volatile("" : "+v"(fr), "+v"(fq));
        const int b = u.pm >> 5, col0 = u.pn * BM + wc * 32 + 8 * fq;
        f32x4 g4[2][2], gm[2][2];
#pragma unroll
        for (int bj = 0; bj < 2; ++bj)
#pragma unroll
            for (int n = 0; n < 2; ++n) { const int c = col0 + bj * HALF + 4 * n; g4[bj][n] = *(const f32x4*)(gt + b * 6144 + c);
                gm[bj][n] = xa ? *(const f32x4*)(gnext + c) * (*(const f32x4*)(scnext + b * 6144 + c) + 1.0f) : (f32x4){0.f, 0.f, 0.f, 0.f}; }
#pragma unroll
        for (int ai = 0; ai < 2; ++ai)
#pragma unroll
            for (int m = 0; m < 4; ++m) {
                const int row = u.pm * BM + ai * HALF + wr * 64 + m * 16 + fr; const size_t off = (size_t)row * 1024 + col0;
                float ssq = 0.f;
#pragma unroll
                for (int bj = 0; bj < 2; ++bj) {
                    const f32x4 x0 = *(const f32x4*)(xin + off + bj * HALF) + g4[bj][0] * acc[ai][bj][m][0], x1 = *(const f32x4*)(xin + off + bj * HALF + 4) + g4[bj][1] * acc[ai][bj][m][1];
                    *(f32x4*)(xout + off + bj * HALF) = x0; *(f32x4*)(xout + off + bj * HALF + 4) = x1;
                    ssq += (x0[0] * x0[0] + x0[1] * x0[1]) + (x0[2] * x0[2] + x0[3] * x0[3]) + (x1[0] * x1[0] + x1[1] * x1[1]) + (x1[2] * x1[2] + x1[3] * x1[3]);
                    if (xa) { const f32x4 a0 = x0 * gm[bj][0], a1 = x1 * gm[bj][1];
                        u32x4 w; w.x = cvt_pk_bf16(a0[0], a0[1]); w.y = cvt_pk_bf16(a0[2], a0[3]); w.z = cvt_pk_bf16(a1[0], a1[1]); w.w = cvt_pk_bf16(a1[2], a1[3]);
                        *(u32x4*)(xa + off + bj * HALF) = w; }
                }
                ssq += __shfl_xor(ssq, 16); ssq += __shfl_xor(ssq, 32);
                if (fq == 0) atomicAdd(rowss + row, ssq);
                if (m & 1) asm volatile("" ::: "memory");
            }
    }
};

struct EpiFinal {
    static constexpr bool PERM = true, APERM = false, AFTER_DRAIN = false;
    const float* xin; float* out; const float* gt; const float* gfin; float* rowss; unsigned* cnt;
    __device__ __forceinline__ void operator()(f32x4 (&acc)[2][2][4][2], const Unit& u, int wr, int wc, int fr_, int fq_) const {
        int fr = fr_, fq = fq_; asm volatile("" : "+v"(fr), "+v"(fq));
        const int b = u.pm >> 5, col0 = u.pn * BM + wc * 32 + 8 * fq;
        {
            f32x4 g4[2][2];
#pragma unroll
            for (int bj = 0; bj < 2; ++bj)
#pragma unroll
                for (int n = 0; n < 2; ++n) g4[bj][n] = *(const f32x4*)(gt + b * 6144 + col0 + bj * HALF + 4 * n);
#pragma unroll
            for (int ai = 0; ai < 2; ++ai)
#pragma unroll
                for (int m = 0; m < 4; ++m) {
                    const int row = u.pm * BM + ai * HALF + wr * 64 + m * 16 + fr; const size_t off = (size_t)row * 1024 + col0;
                    float ssq = 0.f;
#pragma unroll
                    for (int bj = 0; bj < 2; ++bj) {
                        const f32x4 x0 = *(const f32x4*)(xin + off + bj * HALF) + g4[bj][0] * acc[ai][bj][m][0], x1 = *(const f32x4*)(xin + off + bj * HALF + 4) + g4[bj][1] * acc[ai][bj][m][1];
                        acc[ai][bj][m][0] = x0; acc[ai][bj][m][1] = x1;
                        ssq += (x0[0] * x0[0] + x0[1] * x0[1]) + (x0[2] * x0[2] + x0[3] * x0[3]) + (x1[0] * x1[0] + x1[1] * x1[1]) + (x1[2] * x1[2] + x1[3] * x1[3]);
                    }
                    ssq += __shfl_xor(ssq, 16); ssq += __shfl_xor(ssq, 32);
                    if (fq == 0) atomicAdd(rowss + row, ssq);
                    if (m & 1) asm volatile("" ::: "memory");
                }
        }
        asm volatile("s_waitcnt vmcnt(0)" ::: "memory"); __builtin_amdgcn_s_barrier(); asm volatile("" ::: "memory");
        if (wr == 0 && wc == 0 && fr == 0 && fq == 0) __hip_atomic_fetch_add(cnt + u.pm, 1u, __ATOMIC_RELAXED, __HIP_MEMORY_SCOPE_AGENT);
        { unsigned spins = 0; while (__hip_atomic_load(cnt + u.pm, __ATOMIC_RELAXED, __HIP_MEMORY_SCOPE_AGENT) < 4u && ++spins < (1u << 22)) __builtin_amdgcn_s_sleep(2); }
        asm volatile("" ::: "memory");
        f32x4 gf[2][2];
#pragma unroll
        for (int bj = 0; bj < 2; ++bj)
#pragma unroll
            for (int n = 0; n < 2; ++n) gf[bj][n] = *(const f32x4*)(gfin + col0 + bj * HALF + 4 * n);
#pragma unroll
        for (int ai = 0; ai < 2; ++ai)
#pragma unroll
            for (int m = 0; m < 4; ++m) {
                const int row = u.pm * BM + ai * HALF + wr * 64 + m * 16 + fr; const size_t off = (size_t)row * 1024 + col0;
                const float rstd = __builtin_amdgcn_rsqf(__hip_atomic_load(rowss + row, __ATOMIC_RELAXED, __HIP_MEMORY_SCOPE_AGENT) * (1.0f / 1024.0f) + EPS_);
#pragma unroll
                for (int bj = 0; bj < 2; ++bj) { *(f32x4*)(out + off + bj * HALF) = acc[ai][bj][m][0] * rstd * gf[bj][0]; *(f32x4*)(out + off + bj * HALF + 4) = acc[ai][bj][m][1] * rstd * gf[bj][1]; }
            }
    }
};

template <int CTRL> __device__ __forceinline__ float dpp_ror(float x) { return __int_as_float(__builtin_amdgcn_update_dpp(0, __float_as_int(x), CTRL, 0xf, 0xf, true)); }
struct EpiUpConv {
    static constexpr bool PERM = true, APERM = true, AFTER_DRAIN = false;
    bf16_t* act; const float* rowss; const float* bias; const float* cw; const float* cb; float* halo; unsigned* flags; PG8_LAS float* tails;
    static __device__ __forceinline__ float shr1_old(float old, float x) { return __int_as_float(__builtin_amdgcn_update_dpp(__float_as_int(old), __float_as_int(x), 0x111, 0xf, 0xf, false)); }
    __device__ __forceinline__ void operator()(f32x4 (&acc)[2][2][4][2], const Unit& u, int wr, int wc, int fr_, int fq_) const {
        int fr = fr_, fq = fq_; asm volatile("" : "+v"(fr), "+v"(fq));
        const int b = u.pm >> 5, pn = u.pn, colp = wc * 32 + 8 * fq;
        f32x4 w0[2][2], w1[2][2], w2[2][2], cbv[2][2];
#define UPC_LOADW(n) do { _Pragma("unroll") for (int bj = 0; bj < 2; ++bj) { const int ch = bj * 3072 + pn * 128 + colp + 4 * (n); \
                w0[n][bj] = *(const f32x4*)(cw + ch); w1[n][bj] = *(const f32x4*)(cw + 6144 + ch); w2[n][bj] = *(const f32x4*)(cw + 2 * 6144 + ch); cbv[n][bj] = *(const f32x4*)(cb + ch); } } while (0)
        UPC_LOADW(0);
        {
            f32x4 bv[2][2];
#pragma unroll
            for (int bj = 0; bj < 2; ++bj)
#pragma unroll
                for (int n = 0; n < 2; ++n) bv[bj][n] = *(const f32x4*)(bias + b * 6144 + pn * 256 + bj * 128 + colp + 4 * n);
#pragma unroll
            for (int ai = 0; ai < 2; ++ai) {
                const f32x4 ss = *(const f32x4*)(rowss + u.pm * BM + ai * HALF + wr * 64 + 4 * fr);
#pragma unroll
                for (int m = 0; m < 4; ++m) {
                    const float rstd = __builtin_amdgcn_rsqf(ss[m] * (1.0f / 1024.0f) + EPS_);
#pragma unroll
                    for (int bj = 0; bj < 2; ++bj)
#pragma unroll
                        for (int n = 0; n < 2; ++n) acc[ai][bj][m][n] = acc[ai][bj][m][n] * rstd + bv[bj][n];
                }
            }
        }
        if (fr == 15) {
#pragma unroll
            for (int ai = 0; ai < 2; ++ai)
#pragma unroll
                for (int bj = 0; bj < 2; ++bj)
#pragma unroll
                    for (int n = 0; n < 2; ++n) {
                        *(PG8_LAS f32x4*)(tails + ((2 * ai + wr) * 2 + 0) * 256 + bj * 128 + colp + 4 * n) = acc[ai][bj][2][n];
                        *(PG8_LAS f32x4*)(tails + ((2 * ai + wr) * 2 + 1) * 256 + bj * 128 + colp + 4 * n) = acc[ai][bj][3][n]; }
            if (wr == 1) {
#pragma unroll
                for (int j = 0; j < 2; ++j) {
                    unsigned long long* hp = (unsigned long long*)(halo + ((size_t)(u.pm * 24 + pn) * 2 + j) * 256 + colp);
#pragma unroll
                    for (int bj = 0; bj < 2; ++bj)
#pragma unroll
                        for (int n = 0; n < 2; ++n) { const f32x4 v = acc[1][bj][2 + j][n];
                            __hip_atomic_store(hp + (bj * 128 + 4 * n) / 2, ((unsigned long long)__float_as_uint(v[1]) << 32) | __float_as_uint(v[0]), __ATOMIC_RELAXED, __HIP_MEMORY_SCOPE_AGENT);
                            __hip_atomic_store(hp + (bj * 128 + 4 * n) / 2 + 1, ((unsigned long long)__float_as_uint(v[3]) << 32) | __float_as_uint(v[2]), __ATOMIC_RELAXED, __HIP_MEMORY_SCOPE_AGENT); }
                }
            }
        }
        asm volatile("s_waitcnt vmcnt(0) lgkmcnt(0)" ::: "memory"); __builtin_amdgcn_s_barrier(); asm volatile("" ::: "memory");
        if (wr == 1 && wc == 0 && fr == 0 && fq == 0) __hip_atomic_store(flags + u.pm * 24 + pn, 1u, __ATOMIC_RELAXED, __HIP_MEMORY_SCOPE_AGENT);
        u32x2 held[2][4];
#pragma unroll
        for (int n = 0; n < 2; ++n) {
            if (n == 1) UPC_LOADW(1);
#pragma unroll
            for (int aix = 0; aix < 2; ++aix) {
                const int ai = 1 - aix, g = 2 * ai + wr;
                f32x4 t14[2], t15[2];
                if (g > 0) {
#pragma unroll
                    for (int bj = 0; bj < 2; ++bj) { t14[bj] = *(const PG8_LAS f32x4*)(tails + ((g - 1) * 2 + 0) * 256 + bj * 128 + colp + 4 * n); t15[bj] = *(const PG8_LAS f32x4*)(tails + ((g - 1) * 2 + 1) * 256 + bj * 128 + colp + 4 * n); }
                } else if ((u.pm & 31) == 0) {
                    t14[0] = t14[1] = t15[0] = t15[1] = (f32x4){0.f, 0.f, 0.f, 0.f};
                } else {
                    unsigned* fl = flags + (u.pm - 1) * 24 + pn; unsigned spins = 0;
                    while (__hip_atomic_load(fl, __ATOMIC_RELAXED, __HIP_MEMORY_SCOPE_AGENT) == 0u && ++spins < (1u << 22)) __builtin_amdgcn_s_sleep(2);
                    asm volatile("" ::: "memory");
                    const unsigned long long* hp = (const unsigned long long*)(halo + ((size_t)((u.pm - 1) * 24 + pn) * 2) * 256 + colp);
#pragma unroll
                    for (int bj = 0; bj < 2; ++bj) {
                        const unsigned long long a0 = __hip_atomic_load(hp + (bj * 128 + 4 * n) / 2, __ATOMIC_RELAXED, __HIP_MEMORY_SCOPE_AGENT), a1 = __hip_atomic_load(hp + (bj * 128 + 4 * n) / 2 + 1, __ATOMIC_RELAXED, __HIP_MEMORY_SCOPE_AGENT);
                        const unsigned long long c0 = __hip_atomic_load(hp + 128 + (bj * 128 + 4 * n) / 2, __ATOMIC_RELAXED, __HIP_MEMORY_SCOPE_AGENT), c1 = __hip_atomic_load(hp + 128 + (bj * 128 + 4 * n) / 2 + 1, __ATOMIC_RELAXED, __HIP_MEMORY_SCOPE_AGENT);
                        t14[bj] = (f32x4){__uint_as_float((unsigned)a0), __uint_as_float((unsigned)(a0 >> 32)), __uint_as_float((unsigned)a1), __uint_as_float((unsigned)(a1 >> 32))};
                        t15[bj] = (f32x4){__uint_as_float((unsigned)c0), __uint_as_float((unsigned)(c0 >> 32)), __uint_as_float((unsigned)c1), __uint_as_float((unsigned)(c1 >> 32))}; }
                }
                f32x4 y[2][4];
#pragma unroll
                for (int bj = 0; bj < 2; ++bj) {
                    const f32x4 x0 = acc[ai][bj][0][n], x1 = acc[ai][bj][1][n], x2 = acc[ai][bj][2][n], x3 = acc[ai][bj][3][n];
                    f32x4 s3, s2;
#pragma unroll
                    for (int e = 0; e < 4; ++e) { s3[e] = shr1_old(t15[bj][e], x3[e]); s2[e] = shr1_old(t14[bj][e], x2[e]); }
                    y[bj][0] = cbv[n][bj] + w2[n][bj] * x0 + w1[n][bj] * s3 + w0[n][bj] * s2;
                    y[bj][1] = cbv[n][bj] + w2[n][bj] * x1 + w1[n][bj] * x0 + w0[n][bj] * s3;
                    y[bj][2] = cbv[n][bj] + w2[n][bj] * x2 + w1[n][bj] * x1 + w0[n][bj] * x0;
                    y[bj][3] = cbv[n][bj] + w2[n][bj] * x3 + w1[n][bj] * x2 + w0[n][bj] * x1;
                }
#pragma unroll
                for (int m = 0; m < 4; ++m) {
                    f32x4 o;
#pragma unroll
                    for (int e = 0; e < 4; ++e) o[e] = gelu_mul(y[1][m][e], y[0][m][e]);
                    u32x2 w; w.x = cvt_pk_bf16(o[0], o[1]); w.y = cvt_pk_bf16(o[2], o[3]);
                    if (n == 0) held[ai][m] = w;
                    else { u32x4 ww; ww.x = held[ai][m].x; ww.y = held[ai][m].y; ww.z = w.x; ww.w = w.y;
                        *(u32x4*)(act + (size_t)(u.pm * BM + ai * HALF + wr * 64 + 4 * fr + m) * 3072 + pn * 128 + colp) = ww; }
                }
                asm volatile("" ::: "memory");
            }
        }
#undef UPC_LOADW
        asm volatile("s_waitcnt lgkmcnt(0)" ::: "memory"); __builtin_amdgcn_s_barrier(); asm volatile("" ::: "memory");
    }
};
template <class Epi, class Sched, bool ALIGN_EPI = false, bool SP2 = false>
__device__ __forceinline__ void gemm_phase(PG8_LAS unsigned char* lds, const Gemm g, const Sched& S, const Epi& E, int tid_in) {
    int tid_l = tid_in; asm volatile("" : "+v"(tid_l));
    const int tid = tid_l, wid = __builtin_amdgcn_readfirstlane(tid >> 6), lane = tid & 63, wr = wid >> 2, wc = wid & 3, fr = lane & 15, fq = lane >> 4;
    const int K = g.K, nt = K / BK;
    unsigned voffA[2], voffB[2];
#pragma unroll
    for (int i = 0; i < 2; ++i) { int R, C; stage_rc(tid * 16 + i * 8192, R, C); const int Rb = Epi::PERM ? ((R & ~31) + perm32(R & 31)) : R;
        const int Ra = Epi::APERM ? ((R & ~63) + 4 * (R & 15) + ((R >> 4) & 3)) : R;
        voffA[i] = (unsigned)(Ra * K + C) * 2u; voffB[i] = (unsigned)(Rb * K + C) * 2u; }
    const size_t kstep = (size_t)(BK * 2);
    const size_t hstep = (size_t)HALF * K * 2;
    const size_t tstep = 2 * hstep;
    const unsigned ldsw = (unsigned)wid * 1024u;
    const int aoff = lds_byte(wr * 64 + fr, fq * 8), boff = lds_byte(wc * 32 + fr, fq * 8);
#define PG8_SA(b, h) (((b) * 2 + (h)) * HTB)
#define PG8_SB(b, h) ((4 + (b) * 2 + (h)) * HTB)
#define PG8_STAGE(bufoff, gbase, voff) do { _Pragma("unroll") for (int _i = 0; _i < 2; ++_i) \
        __builtin_amdgcn_global_load_lds((const unsigned*)((const char*)(gbase) + (voff)[_i]), (PG8_LAS unsigned*)(lds + (bufoff) + ldsw + _i * 8192), 16, 0, 0); } while (0)
#define PG8_LDA(dst, b, h) do { _Pragma("unroll") for (int m = 0; m < 4; ++m) _Pragma("unroll") for (int k = 0; k < 2; ++k) dst[m][k] = *(const PG8_LAS bf16x8*)(lds + PG8_SA(b, h) + aoff + m * 2048 + k * 1024); } while (0)
#define PG8_LDB(dst, b, h) do { _Pragma("unroll") for (int n = 0; n < 2; ++n) _Pragma("unroll") for (int k = 0; k < 2; ++k) dst[n][k] = *(const PG8_LAS bf16x8*)(lds + PG8_SB(b, h) + boff + n * 2048 + k * 1024); } while (0)
#define PG8_MMA(ai, bj, At, Bt) do { __builtin_amdgcn_s_setprio(1); _Pragma("unroll") for (int m = 0; m < 4; ++m) _Pragma("unroll") for (int n = 0; n < 2; ++n) _Pragma("unroll") for (int k = 0; k < 2; ++k) \
        acc[ai][bj][m][n] = __builtin_amdgcn_mfma_f32_16x16x32_bf16(Bt[n][k], At[m][k], acc[ai][bj][m][n], 0, 0, 0); __builtin_amdgcn_s_setprio(0); } while (0)
#define PG8_WAIT_V(n) asm volatile("s_waitcnt vmcnt(" #n ")" ::: "memory")
#define PG8_WAIT_L(n) asm volatile("s_waitcnt lgkmcnt(" #n ")" ::: "memory")
#define PG8_BAR __builtin_amdgcn_s_barrier()
#define PG8_SCHED __builtin_amdgcn_sched_barrier(0)
    Unit cur, nxt; int ui = 0;
    if (!S.next(0, cur)) return;
    f32x4 acc[2][2][4][2];
#pragma unroll
    for (int a = 0; a < 2; ++a)
#pragma unroll
        for (int b = 0; b < 2; ++b)
#pragma unroll
            for (int m = 0; m < 4; ++m)
#pragma unroll
                for (int n = 0; n < 2; ++n) acc[a][b][m][n] = (f32x4){0.f, 0.f, 0.f, 0.f};
    bf16x8 At[4][2], B0[2][2], B1[2][2];
    const char* cA = (const char*)g.A + (size_t)cur.pm * tstep; const char* cB = (const char*)g.Bt + (size_t)cur.pn * tstep;
    S.a_ready(cur);
    if constexpr (SP2) {
        PG8_STAGE(PG8_SB(0, 0), cB, voffB); PG8_STAGE(PG8_SB(0, 1), cB + hstep, voffB); PG8_STAGE(PG8_SA(0, 0), cA, voffA); PG8_STAGE(PG8_SA(0, 1), cA + hstep, voffA);
        if (wr == 1) PG8_BAR;
        PG8_WAIT_V(2); PG8_BAR;
        PG8_STAGE(PG8_SB(1, 0), cB + kstep, voffB); PG8_STAGE(PG8_SA(1, 0), cA + kstep, voffA); PG8_STAGE(PG8_SB(1, 1), cB + hstep + kstep, voffB);
        PG8_WAIT_V(6); PG8_BAR;
    } else {
        PG8_STAGE(PG8_SB(0, 0), cB, voffB); PG8_STAGE(PG8_SA(0, 0), cA, voffA); PG8_STAGE(PG8_SB(0, 1), cB + hstep, voffB); PG8_STAGE(PG8_SA(0, 1), cA + hstep, voffA);
        if (wr == 1) PG8_BAR;
        PG8_WAIT_V(4); PG8_BAR;
        PG8_STAGE(PG8_SB(1, 0), cB + kstep, voffB); PG8_STAGE(PG8_SA(1, 0), cA + kstep, voffA); PG8_STAGE(PG8_SB(1, 1), cB + hstep + kstep, voffB);
        PG8_WAIT_V(6); PG8_BAR;
    }
    for (;;) {
        const bool has_next = S.next(ui + 1, nxt);
        const char* nA = has_next ? (const char*)g.A + (size_t)nxt.pm * tstep : cA; const char* nB = has_next ? (const char*)g.Bt + (size_t)nxt.pn * tstep : cB;
        for (int t = 0; t < nt; t += 2) {
            asm volatile("" : "+v"(voffA[0]), "+v"(voffA[1]), "+v"(voffB[0]), "+v"(voffB[1]));
            const bool last = (t == nt - 2);
            const char* a1 = cA + (size_t)(t + 1) * kstep;
            const char* a2 = last ? nA : cA + (size_t)(t + 2) * kstep; const char* b2 = last ? nB : cB + (size_t)(t + 2) * kstep;
            const char* a3 = a2 + kstep; const char* b3 = b2 + kstep;
            if (last && has_next) S.a_ready(nxt);
            if constexpr (SP2) {
            PG8_LDB(B0, 0, 0); PG8_LDB(B1, 0, 1); PG8_SCHED; PG8_LDA(At, 0, 0); PG8_STAGE(PG8_SA(1, 1), a1 + hstep, voffA);
            PG8_WAIT_V(8); PG8_WAIT_L(0); PG8_BAR; PG8_MMA(0, 0, At, B0); PG8_MMA(0, 1, At, B1); PG8_BAR; PG8_SCHED;
            PG8_LDA(At, 0, 1); PG8_STAGE(PG8_SB(0, 0), b2, voffB); PG8_STAGE(PG8_SB(0, 1), b2 + hstep, voffB); PG8_STAGE(PG8_SA(0, 0), a2, voffA);
            PG8_WAIT_V(8); PG8_WAIT_L(0); PG8_BAR; PG8_MMA(1, 0, At, B0); PG8_MMA(1, 1, At, B1); PG8_BAR; PG8_SCHED;
            PG8_LDB(B0, 1, 0); PG8_LDB(B1, 1, 1); PG8_SCHED; PG8_LDA(At, 1, 0); PG8_STAGE(PG8_SA(0, 1), a2 + hstep, voffA);
            PG8_WAIT_V(8); PG8_WAIT_L(0); PG8_BAR; PG8_MMA(0, 0, At, B0); PG8_MMA(0, 1, At, B1); PG8_BAR; PG8_SCHED;
            PG8_LDA(At, 1, 1); PG8_STAGE(PG8_SB(1, 0), b3, voffB); PG8_STAGE(PG8_SB(1, 1), b3 + hstep, voffB); PG8_STAGE(PG8_SA(1, 0), a3, voffA);
            PG8_WAIT_V(8); PG8_WAIT_L(0); PG8_BAR; PG8_MMA(1, 0, At, B0); PG8_MMA(1, 1, At, B1); PG8_BAR; PG8_SCHED;
            } else {
            PG8_LDB(B0, 0, 0); PG8_SCHED; PG8_LDA(At, 0, 0); PG8_STAGE(PG8_SA(1, 1), a1 + hstep, voffA);
            PG8_WAIT_L(8); PG8_BAR; PG8_WAIT_L(0); PG8_MMA(0, 0, At, B0); PG8_BAR; PG8_SCHED;
            PG8_LDB(B1, 0, 1); PG8_STAGE(PG8_SB(0, 0), b2, voffB);
            PG8_BAR; PG8_WAIT_L(0); PG8_MMA(0, 1, At, B1); PG8_BAR;
            PG8_LDA(At, 0, 1); PG8_STAGE(PG8_SA(0, 0), a2, voffA);
            PG8_BAR; PG8_WAIT_L(0); PG8_MMA(1, 0, At, B0); PG8_BAR; PG8_SCHED;
            PG8_STAGE(PG8_SB(0, 1), b2 + hstep, voffB);
            PG8_WAIT_V(6); PG8_BAR; PG8_MMA(1, 1, At, B1); PG8_BAR;
            PG8_LDB(B0, 1, 0); PG8_SCHED; PG8_LDA(At, 1, 0); PG8_STAGE(PG8_SA(0, 1), a2 + hstep, voffA);
            PG8_WAIT_L(8); PG8_BAR; PG8_WAIT_L(0); PG8_MMA(0, 0, At, B0); PG8_BAR; PG8_SCHED;
            PG8_LDB(B1, 1, 1); PG8_STAGE(PG8_SB(1, 0), b3, voffB);
            PG8_BAR; PG8_WAIT_L(0); PG8_MMA(0, 1, At, B1); PG8_BAR;
            PG8_LDA(At, 1, 1); PG8_STAGE(PG8_SA(1, 0), a3, voffA);
            PG8_BAR; PG8_WAIT_L(0); PG8_MMA(1, 0, At, B0); PG8_BAR; PG8_SCHED;
            PG8_STAGE(PG8_SB(1, 1), b3 + hstep, voffB);
            PG8_WAIT_V(6); PG8_BAR; PG8_MMA(1, 1, At, B1); PG8_BAR;
            }
        }
        if constexpr (ALIGN_EPI) { if (wr == 0) PG8_BAR; }
        if constexpr (!Epi::AFTER_DRAIN) { E(acc, cur, wr, wc, fr, fq); S.done(cur); }
        if (!has_next) break;
#pragma unroll
        for (int a = 0; a < 2; ++a)
#pragma unroll
            for (int b = 0; b < 2; ++b)
#pragma unroll
                for (int m = 0; m < 4; ++m)
#pragma unroll
                    for (int n = 0; n < 2; ++n) acc[a][b][m][n] = (f32x4){0.f, 0.f, 0.f, 0.f};
        cur = nxt; cA = nA; cB = nB; ++ui;
        if constexpr (ALIGN_EPI) { if (wr == 1) PG8_BAR; }
    }
    PG8_WAIT_V(0);
    if constexpr (!ALIGN_EPI) { if (wr == 0) PG8_BAR; }
    PG8_BAR;
    if constexpr (Epi::AFTER_DRAIN) { E.fused(acc, cur, wr, wc, fr, fq, lds, wid, lane); S.done(cur); }
#undef PG8_SA
#undef PG8_SB
#undef PG8_STAGE
#undef PG8_LDA
#undef PG8_LDB
#undef PG8_MMA
#undef PG8_WAIT_V
#undef PG8_WAIT_L
#undef PG8_BAR
#undef PG8_SCHED
}
}

#include <hip/hip_bf16.h>
#include <cmath>
namespace attn_body {
using bf16=__hip_bfloat16;
using bf16x8=__attribute__((ext_vector_type(8)))short;
using s16x4=__attribute__((ext_vector_type(4)))short;
using f32x16=__attribute__((ext_vector_type(16)))float;
using u32x4=__attribute__((ext_vector_type(4)))unsigned;
constexpr int BATCH=2,NHEAD=16,SEQ=8192,D=64,DM=NHEAD*D;
constexpr int NW=8,QBLK=32,QB=QBLK*NW,KVBLK=64,NQB=SEQ/QB;
constexpr int ATTN_PITCH=DM, ATTN_UNIT_ROWS=QB;
__device__ __forceinline__ int crow(int r,int hi){return (r&3)+8*(r>>2)+4*hi;}
#define SBAR() __builtin_amdgcn_sched_barrier(0)
__device__ __forceinline__ void cmask(f32x16&p0,f32x16&p1,int jb,int qrel,int hi){
  const float NEG=-INFINITY; int kb=64*jb+4*hi;
  #pragma unroll
  for(int r=0;r<16;++r){int kv=kb+(r&3)+8*(r>>2); if(kv>qrel)p0[r]=NEG; if(kv+32>qrel)p1[r]=NEG;}
}

constexpr int NSLOT=3, SLOTB=8192;
constexpr int LDS_K=0, LDS_V=NSLOT*SLOTB, LDS_WS=3*NSLOT*SLOTB, LDS_OST=LDS_WS+NW*64*4, LDS_BYTES=LDS_OST+NW*4096;
constexpr float C2=0.125f*1.4426950408889634f;
__device__ __forceinline__ void glds16(const void*gsrc,unsigned lds_dst){unsigned keep;
  asm volatile("s_mov_b32 %0, m0\n\ts_mov_b32 m0, %2\n\ts_nop 0\n\tglobal_load_lds_dwordx4 %1, off\n\ts_mov_b32 m0, %0":"=&s"(keep):"v"(gsrc),"s"(lds_dst):"memory");}
__device__ __forceinline__ float max3f(float a,float b,float c){float r;asm("v_max3_f32 %0, %1, %2, %3":"=v"(r):"v"(a),"v"(b),"v"(c));return r;}
__device__ __forceinline__ float max2f(float a,float b){float r;asm("v_max_f32_e32 %0, %1, %2":"=v"(r):"v"(a),"v"(b));return r;}
__device__ __forceinline__ float fadd_s(float a,float b){float r;asm("v_add_f32_e32 %0, %1, %2":"=v"(r):"v"(a),"v"(b));return r;}
__device__ __forceinline__ float fsub_s(float a,float b){float r;asm("v_sub_f32_e32 %0, %1, %2":"=v"(r):"v"(a),"v"(b));return r;}
typedef float f32x2_t __attribute__((ext_vector_type(2))); typedef __bf16 bf16x2_t __attribute__((ext_vector_type(2)));
__device__ __forceinline__ unsigned cvtpk_s(float lo,float hi){f32x2_t v={lo,hi};bf16x2_t b=__builtin_convertvector(v,bf16x2_t);return __builtin_bit_cast(unsigned,b);}
#define WAIT_BAR(N) asm volatile("s_waitcnt vmcnt(" #N ") lgkmcnt(0)\n\ts_barrier":::"memory")

__device__ __forceinline__ void qkt(f32x16&p0,f32x16&p1,const char*Kslot,const bf16x8*qr,const f32x16&negm,int r32,int hi){
  const char*kb=Kslot+hi*1024+r32*16;
  #pragma unroll
  for(int d0=0;d0<4;++d0){
    const bf16x8 b0=*reinterpret_cast<const bf16x8*>(kb+d0*2048);
    const bf16x8 b1=*reinterpret_cast<const bf16x8*>(kb+d0*2048+512);
    if(d0==0){p0=__builtin_amdgcn_mfma_f32_32x32x16_bf16(b0,qr[0],negm,0,0,0);p1=__builtin_amdgcn_mfma_f32_32x32x16_bf16(b1,qr[0],negm,0,0,0);}
    else{p0=__builtin_amdgcn_mfma_f32_32x32x16_bf16(b0,qr[d0],p0,0,0,0);p1=__builtin_amdgcn_mfma_f32_32x32x16_bf16(b1,qr[d0],p1,0,0,0);}}
}
typedef __attribute__((address_space(3))) const char* lds_cptr;
typedef short v4i16_t __attribute__((ext_vector_type(4)));
__device__ __forceinline__ void kload8(bf16x8*kf,lds_cptr kp){
  kf[0]=*(const __attribute__((address_space(3))) bf16x8*)(kp);      kf[1]=*(const __attribute__((address_space(3))) bf16x8*)(kp+512);
  kf[2]=*(const __attribute__((address_space(3))) bf16x8*)(kp+2048); kf[3]=*(const __attribute__((address_space(3))) bf16x8*)(kp+2560);
  kf[4]=*(const __attribute__((address_space(3))) bf16x8*)(kp+4096); kf[5]=*(const __attribute__((address_space(3))) bf16x8*)(kp+4608);
  kf[6]=*(const __attribute__((address_space(3))) bf16x8*)(kp+6144); kf[7]=*(const __attribute__((address_space(3))) bf16x8*)(kp+6656);
}
__device__ __forceinline__ void kload2(bf16x8*kf,lds_cptr kp,int j){ kf[2*j]=*(const __attribute__((address_space(3))) bf16x8*)(kp+j*2048); kf[2*j+1]=*(const __attribute__((address_space(3))) bf16x8*)(kp+j*2048+512); }
__device__ __forceinline__ void kload2p(bf16x8*kf,lds_cptr kp,int jsrc,int jdst){ kf[2*jdst]=*(const __attribute__((address_space(3))) bf16x8*)(kp+jsrc*2048); kf[2*jdst+1]=*(const __attribute__((address_space(3))) bf16x8*)(kp+jsrc*2048+512); }
__device__ __forceinline__ s16x4 vtr(lds_cptr p){ return __builtin_bit_cast(s16x4,__builtin_amdgcn_ds_read_tr16_b64_v4i16((__attribute__((address_space(3))) v4i16_t*)p)); }
__device__ __forceinline__ float rowmax(const f32x16&p0,const f32x16&p1){
  float a=max3f(p0[0],p0[1],p1[0]),b=max3f(p0[2],p0[3],p1[1]);a=max3f(a,p1[2],p1[3]);
  #pragma unroll
  for(int r=4;r<16;r+=4){a=max3f(a,p0[r],p0[r+1]);b=max3f(b,p0[r+2],p0[r+3]);a=max3f(a,p1[r],p1[r+1]);b=max3f(b,p1[r+2],p1[r+3]);}
  const float m=max2f(a,b);
  auto rr=__builtin_amdgcn_permlane32_swap(__float_as_uint(m),__float_as_uint(m),false,false);
  return max2f(__uint_as_float(rr[0]),__uint_as_float(rr[1]));
}
__device__ __forceinline__ void pv(f32x16*o,int vb,bf16x8 pa0,bf16x8 pa1,bf16x8 pa2,bf16x8 pa3){
  #pragma unroll
  for(int d0=0;d0<4;++d0){s16x4 lo[4],hi[4];
    #pragma unroll
    for(int ks=0;ks<4;++ks){
      asm volatile("ds_read_b64_tr_b16 %0,%1 offset:%c2":"=&v"(lo[ks]):"v"(vb),"i"(d0*4096+ks*1024):"memory");
      asm volatile("ds_read_b64_tr_b16 %0,%1 offset:%c2":"=&v"(hi[ks]):"v"(vb),"i"(d0*4096+ks*1024+512):"memory");}
    asm volatile("s_waitcnt lgkmcnt(0)":::"memory");SBAR();
    #define PK(k) (bf16x8){lo[k][0],lo[k][1],lo[k][2],lo[k][3],hi[k][0],hi[k][1],hi[k][2],hi[k][3]}
    o[d0]=__builtin_amdgcn_mfma_f32_32x32x16_bf16(pa0,PK(0),o[d0],0,0,0);
    o[d0]=__builtin_amdgcn_mfma_f32_32x32x16_bf16(pa1,PK(1),o[d0],0,0,0);
    o[d0]=__builtin_amdgcn_mfma_f32_32x32x16_bf16(pa2,PK(2),o[d0],0,0,0);
    o[d0]=__builtin_amdgcn_mfma_f32_32x32x16_bf16(pa3,PK(3),o[d0],0,0,0);
    #undef PK
  }
}

#ifndef ATTN_STORE16
#define ATTN_STORE16(p,v) (*(u32x4*)(p)=(v))
#endif
template<int THRL> __device__ __forceinline__ void attn_unit(int b,int h,int qb,const bf16*Q,const bf16*__restrict__ K,const bf16*__restrict__ V,bf16*O,char*shm,const bool comb,const float lam,const int tid_in){
  int tid_l=tid_in; asm volatile("":"+v"(tid_l)); const int tid=tid_l,lane=tid&63,r32=lane&31,hi=lane>>5; const int wid=__builtin_amdgcn_readfirstlane(tid>>6);
  const long rowbase=(long)b*SEQ; const int q0=qb*QB;
  const bf16*Qw=Q+(rowbase+q0+wid*QBLK)*DM+h*D;
  const bf16*Kh=K+rowbase*DM+h*D,*Vh=V+rowbase*DM+h*D;
  const unsigned lds0=(unsigned)(uintptr_t)shm;
  float*wsf=(float*)(shm+LDS_WS)+wid*64;
  const bf16*ksrc=Kh+(long)lane*DM+wid*8;
  const bf16*vsrc=Vh+(long)(16*(wid&3)+(lane>>2))*DM+(wid>>2)*32+(lane&3)*8;
  const unsigned kdst=lds0+LDS_K+wid*1024, vdst=lds0+LDS_V+wid*1024;
  #define DMA_K(t,slot) glds16(ksrc+(long)(t)*KVBLK*DM,(unsigned)__builtin_amdgcn_readfirstlane(kdst+(slot)))
  #define DMA_V(t,slot) do{ glds16(vsrc+(long)(t)*KVBLK*DM,(unsigned)__builtin_amdgcn_readfirstlane(vdst+2*(slot))); glds16(vsrc+64+(long)(t)*KVBLK*DM,(unsigned)__builtin_amdgcn_readfirstlane(vdst+8192+2*(slot))); }while(0)
  const int vb0=(int)(lds0+LDS_V)+((lane>>4)&1)*32+(lane&3)*8+(4*hi+((lane&15)>>2))*64;
  const char*Kbase=shm+LDS_K; bf16x8 kf[4];
  const lds_cptr shm3=(lds_cptr)shm; const lds_cptr kp0=shm3+LDS_K+hi*1024+r32*16; const lds_cptr vp0=shm3+LDS_V+((lane>>4)&1)*32+(lane&3)*8+(4*hi+((lane&15)>>2))*64;
  const int NT=(q0+QB)/KVBLK;
  DMA_K(0,0);DMA_V(0,0);DMA_K(1,SLOTB);
  bf16x8 qr[4];
  #pragma unroll
  for(int d0=0;d0<4;++d0)qr[d0]=*reinterpret_cast<const bf16x8*>(&Qw[(long)r32*DM+d0*16+hi*8]);
  float mhat=0.f,l_reg=0.f;f32x16 o[4];o[0]=f32x16{};o[1]=f32x16{};o[2]=f32x16{};o[3]=f32x16{};f32x16 negm=f32x16{};asm volatile("":"+v"(negm));
  const int qrel=wid*QBLK+r32;
  #define CMASK(P0,P1,t) do{int jb_=(t)-(NT-4); if(jb_>=0)cmask(P0,P1,jb_,qrel,hi);}while(0)
  bool resc=false;
  #define START(P0,P1) do{ const float rm=rowmax(P0,P1); resc=false; \
    { const float dl=rm; mhat=fadd_s(mhat,dl); \
      _Pragma("unroll") for(int r=0;r<16;++r){P0[r]=fsub_s(P0[r],dl);P1[r]=fsub_s(P1[r],dl);} \
      _Pragma("unroll") for(int r=0;r<16;++r)negm[r]=-mhat; asm volatile("":"+v"(negm)); } \
    _Pragma("unroll") for(int r=0;r<16;++r)P0[r]=__builtin_amdgcn_exp2f(P0[r]); }while(0)
  #define RESC() do{ if(resc){ asm volatile("s_waitcnt lgkmcnt(0)":::"memory"); \
      _Pragma("unroll") for(int d_=0;d_<4;++d_) _Pragma("unroll") for(int r=0;r<16;++r)o[d_][r]*=wsf[crow(r,hi)]; } }while(0)
  f32x16 pA0,pA1,pB0,pB1;
  int sl_prev=0,sl_cur=0,sl_next=SLOTB;
  #define ROT() do{sl_prev=sl_cur;sl_cur=sl_next;sl_next=(sl_next==(NSLOT-1)*SLOTB)?0:sl_next+SLOTB;}while(0)
  DMA_K(2,2*SLOTB);
  WAIT_BAR(3);
  qkt(pA0,pA1,Kbase,qr,negm,r32,hi);asm volatile("s_nop 15\n\ts_nop 7":"+v"(pA0),"+v"(pA1));CMASK(pA0,pA1,0);
  START(pA0,pA1);
  _Pragma("unroll") for(int r=0;r<16;++r)pA1[r]=__builtin_amdgcn_exp2f(pA1[r]);
  WAIT_BAR(0);
  DMA_V(1,SLOTB);
  ROT();
  kload2p(kf,kp0+sl_cur,0,0); kload2p(kf,kp0+sl_cur,1,1);
  WAIT_BAR(2);
  s16x4 f0l,f0h,f1l,f1h,f2l,f2h,f3l,f3h; u32x4 pw0,pw1,pw2,pw3;
  #define PKW(P,B) cvtpk_s(P[B],P[B+1])
  #define PAF(k) __builtin_bit_cast(bf16x8,pw##k)
  #define VFRF(F) (bf16x8){F##l[0],F##l[1],F##l[2],F##l[3],F##h[0],F##h[1],F##h[2],F##h[3]}
  #define VRDF(F,d0,ks) do{ F##l=vtr(vp_+((d0)*4096+(ks)*1024)); F##h=vtr(vp_+((d0)*4096+(ks)*1024+512)); }while(0)
  #define PIN(x) asm volatile(""::"v"(x))
  #define MX3(a,b,c) __builtin_fmaxf(__builtin_fmaxf((a),(b)),(c))
  #define GAPA(MF,A0,A1,A2,A3,W0,W1,PW) do{ MF; sacc+=A0; sacc+=A1; sacc+=A2; sacc+=A3; PIN(sacc); W0; W1; PIN(PW); SBAR(); }while(0)
  #define EX(v) __builtin_amdgcn_exp2f(v)
  #define GAPB2(MF,X,B) do{ MF; X[B]=EX(X[B]); X[B+1]=EX(X[B+1]); PIN(X); SBAR(); }while(0)
  #define GAPB3(MF,X,B) do{ MF; X[B]=EX(X[B]); X[B+1]=EX(X[B+1]); X[B+2]=EX(X[B+2]); PIN(X); SBAR(); }while(0)
  #define KRD(G,j) do{ if(G){ kload2p(kf,kp0+sl_next,j,j); SBAR(); } }while(0)
  #define KRA(js,jd) do{ kload2p(kf,kp0+sl_cur,js,jd); SBAR(); }while(0)
  #define MF_ __builtin_amdgcn_mfma_f32_32x32x16_bf16
  #define STEP(C0,C1,P0,P1,t,GK,GV,GL) do{ SBAR(); \
    if(GK){DMA_K((t)+2,sl_prev);} \
    const lds_cptr vp_=vp0+2*sl_prev; \
    VRDF(f0,0,0); SBAR(); float sacc=(P0[0]+P0[1]); \
    GAPA(C0=MF_(kf[0],qr[0],negm,0,0,0), P0[2],P0[3],P0[4],P0[5],     pw0[0]=PKW(P0,0), pw0[1]=PKW(P0,2), pw0); \
    VRDF(f1,1,0); SBAR(); GAPA(C1=MF_(kf[1],qr[0],negm,0,0,0), P0[6],P0[7],P0[8],P0[9],     pw0[2]=PKW(P0,4), pw0[3]=PKW(P0,6), pw0); KRA(2,0); \
    VRDF(f2,2,0); SBAR(); GAPA(C0=MF_(kf[2],qr[1],C0,0,0,0),   P0[10],P0[11],P0[12],P0[13], pw1[0]=PKW(P0,8), pw1[1]=PKW(P0,10), pw1); \
    VRDF(f3,3,0); SBAR(); GAPA(C1=MF_(kf[3],qr[1],C1,0,0,0),   P0[14],P0[15],P1[0],P1[1],   pw1[2]=PKW(P0,12),pw1[3]=PKW(P0,14), pw1); KRA(3,1); \
    GAPA(C0=MF_(kf[0],qr[2],C0,0,0,0),   P1[2],P1[3],P1[4],P1[5],     pw2[0]=PKW(P1,0), pw2[1]=PKW(P1,2), pw2); \
    GAPA(C1=MF_(kf[1],qr[2],C1,0,0,0),   P1[6],P1[7],P1[8],P1[9],     pw2[2]=PKW(P1,4), pw2[3]=PKW(P1,6), pw2); \
    GAPA(C0=MF_(kf[2],qr[3],C0,0,0,0),   P1[10],P1[11],P1[12],P1[13], pw3[0]=PKW(P1,8), pw3[1]=PKW(P1,10), pw3); \
    GAPA(C1=MF_(kf[3],qr[3],C1,0,0,0),   P1[14],P1[15],0.f,0.f,       pw3[2]=PKW(P1,12),pw3[3]=PKW(P1,14), pw3); \
    l_reg+=sacc; \
    if(GV){DMA_V((t)+1,sl_next);} \
    CMASK(C0,C1,t); \
      \
      \
    SBAR(); \
    float mxa_,mxb_; \
    o[0]=MF_(PAF(0),VFRF(f0),o[0],0,0,0); mxa_=MX3(C0[0],C0[1],C1[0]); mxb_=MX3(C0[2],C0[3],C1[1]); mxa_=MX3(mxa_,C1[2],C1[3]); mxa_=MX3(mxa_,C0[4],C0[5]); mxb_=MX3(mxb_,C0[6],C0[7]); PIN(mxa_); PIN(mxb_); SBAR(); VRDF(f0,0,1); SBAR(); \
    o[1]=MF_(PAF(0),VFRF(f1),o[1],0,0,0); mxa_=MX3(mxa_,C1[4],C1[5]); mxb_=MX3(mxb_,C1[6],C1[7]); mxa_=MX3(mxa_,C0[8],C0[9]); mxb_=MX3(mxb_,C0[10],C0[11]); mxa_=MX3(mxa_,C1[8],C1[9]); PIN(mxa_); PIN(mxb_); SBAR(); VRDF(f1,1,1); SBAR(); \
    o[2]=MF_(PAF(0),VFRF(f2),o[2],0,0,0); mxb_=MX3(mxb_,C1[10],C1[11]); mxa_=MX3(mxa_,C0[12],C0[13]); mxb_=MX3(mxb_,C0[14],C0[15]); mxa_=MX3(mxa_,C1[12],C1[13]); mxb_=MX3(mxb_,C1[14],C1[15]); PIN(mxa_); PIN(mxb_); SBAR(); VRDF(f2,2,1); SBAR(); \
    o[3]=MF_(PAF(0),VFRF(f3),o[3],0,0,0); \
    { float rm=__builtin_fmaxf(mxa_,mxb_); { auto rr=__builtin_amdgcn_permlane32_swap(__float_as_uint(rm),__float_as_uint(rm),false,false); rm=__builtin_fmaxf(__uint_as_float(rr[0]),__uint_as_float(rr[1])); } \
      resc=false; \
      if(__builtin_expect(__any(rm>(float)THRL),0)){ const float dl=__builtin_fmaxf(rm,0.f); mhat+=dl; \
        _Pragma("unroll") for(int r=0;r<16;++r){C0[r]-=dl;C1[r]-=dl;} \
        _Pragma("unroll") for(int r=0;r<16;++r)negm[r]=-mhat; asm volatile("":"+v"(negm)); \
        const float f=__builtin_amdgcn_exp2f(-dl); l_reg*=f; if(hi==0)wsf[r32]=f; resc=true; } } \
    SBAR(); VRDF(f3,3,1); SBAR(); \
    GAPB3(o[0]=MF_(PAF(1),VFRF(f0),o[0],0,0,0), C0,0);  VRDF(f0,0,2); SBAR(); \
    GAPB3(o[1]=MF_(PAF(1),VFRF(f1),o[1],0,0,0), C0,3);  VRDF(f1,1,2); SBAR(); \
    GAPB3(o[2]=MF_(PAF(1),VFRF(f2),o[2],0,0,0), C0,6);  VRDF(f2,2,2); SBAR(); \
    GAPB3(o[3]=MF_(PAF(1),VFRF(f3),o[3],0,0,0), C0,9);  VRDF(f3,3,2); SBAR(); \
    GAPB3(o[0]=MF_(PAF(2),VFRF(f0),o[0],0,0,0), C0,12); VRDF(f0,0,3); SBAR(); \
    do{ o[1]=MF_(PAF(2),VFRF(f1),o[1],0,0,0); C0[15]=EX(C0[15]); C1[0]=EX(C1[0]); C1[1]=EX(C1[1]); PIN(C0); PIN(C1); SBAR(); }while(0); VRDF(f1,1,3); SBAR(); \
    GAPB3(o[2]=MF_(PAF(2),VFRF(f2),o[2],0,0,0), C1,2);  VRDF(f2,2,3); SBAR(); \
    GAPB3(o[3]=MF_(PAF(2),VFRF(f3),o[3],0,0,0), C1,5);  VRDF(f3,3,3); SBAR(); \
    GAPB2(o[0]=MF_(PAF(3),VFRF(f0),o[0],0,0,0), C1,8); KRD(GL,0); \
    GAPB2(o[1]=MF_(PAF(3),VFRF(f1),o[1],0,0,0), C1,10); KRD(GL,1); \
    GAPB2(o[2]=MF_(PAF(3),VFRF(f2),o[2],0,0,0), C1,12); \
    GAPB2(o[3]=MF_(PAF(3),VFRF(f3),o[3],0,0,0), C1,14); \
    }while(0)
  int t=1;
  #undef CMASK
  #define CMASK(P0,P1,t) do{}while(0)
  for(;t+5<NT;t+=2){
    STEP(pB0,pB1,pA0,pA1,t,true,true,true);     WAIT_BAR(2); RESC(); ROT();
    STEP(pA0,pA1,pB0,pB1,t+1,true,true,true);   WAIT_BAR(2); RESC(); ROT();
  }
  #undef CMASK
  #define CMASK(P0,P1,t) do{int jb_=(t)-(NT-4); if(jb_>=0)cmask(P0,P1,jb_,qrel,hi);}while(0)
  #define ENDW(tt) do{ if((tt)+2<NT){WAIT_BAR(2);} else {WAIT_BAR(0);} }while(0)
  for(;t+1<NT;t+=2){
    STEP(pB0,pB1,pA0,pA1,t,(t+2<NT),(t+1<NT),(t+1<NT));       ENDW(t);   RESC(); ROT();
    STEP(pA0,pA1,pB0,pB1,t+1,(t+3<NT),(t+2<NT),(t+2<NT));     ENDW(t+1); RESC(); ROT();
  }
  STEP(pB0,pB1,pA0,pA1,NT-1,false,false,false); RESC();
  { float sacc=pB0[0]+pB0[1]; _Pragma("unroll") for(int r=2;r<16;++r)sacc+=pB0[r]; _Pragma("unroll") for(int r=0;r<16;++r)sacc+=pB1[r]; l_reg+=sacc;
    pw0=(u32x4){PKW(pB0,0),PKW(pB0,2),PKW(pB0,4),PKW(pB0,6)};pw1=(u32x4){PKW(pB0,8),PKW(pB0,10),PKW(pB0,12),PKW(pB0,14)};pw2=(u32x4){PKW(pB1,0),PKW(pB1,2),PKW(pB1,4),PKW(pB1,6)};pw3=(u32x4){PKW(pB1,8),PKW(pB1,10),PKW(pB1,12),PKW(pB1,14)};
    SBAR(); pv(o,vb0+2*sl_cur,PAF(0),PAF(1),PAF(2),PAF(3)); }
  #undef PKW
  #undef PAF
  #undef VFRF
  #undef VRDF
  #undef MF_
  #undef PIN
  #undef MX3
  #undef GAPA
  #undef GAPB2
  #undef GAPB3
  #undef EX
  #undef KRD
  #undef KRA
  #undef STEP
  #undef ENDW
  {auto rr=__builtin_amdgcn_permlane32_swap(__float_as_uint(l_reg),__float_as_uint(l_reg),false,false);l_reg=__uint_as_float(rr[0])+__uint_as_float(rr[1]);}
  if(hi==0)wsf[32+r32]=l_reg;asm volatile("s_waitcnt lgkmcnt(0)":::"memory");
  float rli[16];
  #pragma unroll
  for(int r=0;r<16;++r)rli[r]=__builtin_amdgcn_rcpf(wsf[32+crow(r,hi)]);
  bf16*Ow=O+(rowbase+q0+wid*QBLK)*DM+h*D;
  u32x4 prevo[2][4];
  if(comb){
    #pragma unroll
    for(int half=0;half<2;++half)
      #pragma unroll
      for(int i=0;i<4;++i)prevo[half][i]=__builtin_nontemporal_load((const u32x4*)(Ow+(long)(i*8+(lane>>3))*DM+half*64+(lane&7)*8)); }
  { bf16*stg=(bf16*)(shm+LDS_OST)+wid*2048;
    #pragma unroll
    for(int half=0;half<2;++half){
      #pragma unroll
      for(int r=0;r<16;++r){const int orow=crow(r,hi);
        #pragma unroll
        for(int d0=0;d0<2;++d0)stg[orow*64+d0*32+r32]=__float2bfloat16(o[2*half+d0][r]*rli[r]);}
      asm volatile("s_waitcnt lgkmcnt(0)":::"memory");
      #pragma unroll
      for(int i=0;i<4;++i){const int row=i*8+(lane>>3),ch=lane&7; u32x4 v=*(const u32x4*)(stg+row*64+ch*8);
        if(comb){ const u32x4 pv_=prevo[half][i];
          _Pragma("unroll") for(int e=0;e<4;++e){ const float c0=__uint_as_float(v[e]<<16),c1=__uint_as_float(v[e]&0xffff0000u),p0_=__uint_as_float(pv_[e]<<16),p1_=__uint_as_float(pv_[e]&0xffff0000u); v[e]=cvtpk_s(p0_-lam*c0,p1_-lam*c1);} }
        ATTN_STORE16(Ow+(long)row*DM+half*64+ch*8,v);}
      asm volatile("s_waitcnt lgkmcnt(0)":::"memory");
    } }
  asm volatile("s_waitcnt lgkmcnt(0)\n\ts_barrier":::"memory");
  #undef DMA_K
  #undef DMA_V
  #undef CMASK
  #undef START
  #undef RESC
  #undef ROT
}
constexpr int ATTN_LDS_BYTES=LDS_BYTES;
#undef SBAR
#undef WAIT_BAR
}

#define GAS __attribute__((address_space(1)))
#define LAS __attribute__((address_space(3)))
typedef unsigned short bf16;
typedef unsigned v4u __attribute__((ext_vector_type(4)));
typedef float f32x4 __attribute__((ext_vector_type(4)));
typedef short bf16x8 __attribute__((ext_vector_type(8)));
typedef GAS unsigned gu32;
typedef GAS unsigned long long gu64;
#define RLX_AGENT __ATOMIC_RELAXED, __HIP_MEMORY_SCOPE_AGENT
#define LDS_WAIT() asm volatile("s_waitcnt lgkmcnt(0)" ::: "memory")
#define VM_WAIT() asm volatile("s_waitcnt vmcnt(0)" ::: "memory")
__device__ __forceinline__ unsigned long long rt() { return __builtin_amdgcn_s_memrealtime(); }

#define XB_TMO      128
#define XB_XCNT(j)  (256  + 64 * (j))
#define XB_XSUB(j)  (1280 + 64 * (j))
#define XB_XGEN(j)  (2304 + 64 * (j))
#define XB_TOP      3328
#define XB_TOPGEN   3392
#define XCD_BAR_WORDS 3456
#define XB_SPIN_CAP (1u << 18)

__device__ __forceinline__ unsigned xb_ld(unsigned* p)              { return __hip_atomic_load(p, __ATOMIC_RELAXED, __HIP_MEMORY_SCOPE_AGENT); }
__device__ __forceinline__ unsigned xb_add(unsigned* p, unsigned v) { return __hip_atomic_fetch_add(p, v, __ATOMIC_RELAXED, __HIP_MEMORY_SCOPE_AGENT); }
__device__ __forceinline__ unsigned xb_xcc_id() { return (unsigned)__builtin_amdgcn_s_getreg((3 << 11) | 20) & 0xFu; }
#define XB_SPIN(cond, bar) do { unsigned _sp = 0; while (cond) { __builtin_amdgcn_s_sleep(1); \
    if ((++_sp & 255u) == 0u) { if (xb_ld(&(bar)[XB_TMO])) break; if (_sp > XB_SPIN_CAP) { atomicAdd(&(bar)[XB_TMO], 1u); break; } } } } while (0)

struct XcdBarrier {
    unsigned* bar; unsigned x;
    volatile LAS unsigned* st;
};

__device__ __forceinline__ XcdBarrier xcd_barrier_post(unsigned* bar, volatile LAS unsigned* st) {
    XcdBarrier b; b.bar = bar; b.x = xb_xcc_id(); b.st = st;
    if (threadIdx.x == 0) (void)xb_add(&bar[XB_XCNT(b.x)], 1u);
    return b;
}
__device__ __forceinline__ void xcd_barrier_complete(unsigned* bar, unsigned x, unsigned& nloc, unsigned& nx) {
    const unsigned G = gridDim.x * gridDim.y * gridDim.z;
    unsigned sum, cnt, mine, sp = 0u;
    for (;;) {
        sum = 0u; cnt = 0u; mine = 0u;
#pragma unroll
        for (unsigned j = 0; j < 16; ++j) { const unsigned c = xb_ld(&bar[XB_XCNT(j)]); sum += c; cnt += (c > 0u) ? 1u : 0u; mine = (j == x) ? c : mine; }
        if (sum == G) break;
        __builtin_amdgcn_s_sleep(1);
        if ((++sp & 255u) == 0u) { if (xb_ld(&bar[XB_TMO])) break; if (sp > XB_SPIN_CAP) { atomicAdd(&bar[XB_TMO], 1u); break; } }
    }
    nloc = mine > 0u ? mine : 1u; nx = cnt > 0u ? cnt : 1u;
}

__device__ __forceinline__ void xcd_barrier(const XcdBarrier& b) {
    asm volatile("s_waitcnt vmcnt(0)" ::: "memory");
    __syncthreads();
    if (threadIdx.x == 0) {
        unsigned* bar = b.bar;
        __builtin_amdgcn_s_waitcnt(0);
        unsigned nloc = b.st[0], nx = b.st[1];
        if (nloc == 0u) { xcd_barrier_complete(bar, b.x, nloc, nx); b.st[0] = nloc; b.st[1] = nx; }
        const unsigned old = xb_add(&bar[XB_XSUB(b.x)], 1u);
        const unsigned gen = old / nloc;
        if (old + 1u == (gen + 1u) * nloc) {
            __builtin_amdgcn_fence(__ATOMIC_RELEASE, "agent");
            asm volatile("s_waitcnt vmcnt(0)" ::: "memory");
            const unsigned og = xb_add(&bar[XB_TOP], 1u);
            const unsigned tg = og / nx;
            if (og + 1u == (tg + 1u) * nx) xb_add(&bar[XB_TOPGEN], 1u);
            else XB_SPIN(xb_ld(&bar[XB_TOPGEN]) == tg, bar);
            __builtin_amdgcn_fence(__ATOMIC_ACQUIRE, "agent");
            xb_add(&bar[XB_XGEN(b.x)], 1u);
            asm volatile("s_waitcnt vmcnt(0)" ::: "memory");
        } else {
            XB_SPIN(xb_ld(&bar[XB_XGEN(b.x)]) == gen, bar);
            __builtin_amdgcn_fence(__ATOMIC_ACQUIRE, "agent");
            asm volatile("s_waitcnt vmcnt(0)" ::: "memory");
        }
    }
    __syncthreads();
}

constexpr int NWAVES = 8, NTHREADS = 512;
constexpr int LDS_BYTES = 159744;
constexpr int LDS_CTL0 = 155648, LDS_MISC = LDS_CTL0 + 320;
typedef unsigned v2u __attribute__((ext_vector_type(2)));
typedef float f32x16 __attribute__((ext_vector_type(16)));

constexpr size_t WS_CTLZERO = 1 * MiB;
constexpr int CW_BAR = 4096;
constexpr size_t WS_FLAGS = 32 * 1024;
constexpr size_t WS_RFLAGS = 48 * 1024;
constexpr size_t WS_FCNT = 52 * 1024;
constexpr size_t WS_MOD = 64 * 1024;
constexpr size_t WS_LAM = 192 * 1024;
constexpr size_t WS_RSS = 256 * 1024;
constexpr size_t WS_RSS0 = 512 * 1024;
constexpr size_t WS_BIASIN = 1 * MiB;
constexpr size_t WS_BIASUP = 1 * MiB + 64 * 1024;
constexpr size_t WS_AGG = 1 * MiB + 512 * 1024;
constexpr size_t WS_COS = 2 * MiB, WS_SIN = 4 * MiB;
constexpr size_t WS_WA = 6 * MiB;
constexpr size_t WS_WOUT = 20 * MiB;
constexpr size_t WS_WDOWN = 22 * MiB;
constexpr size_t WS_RGA = 28 * MiB;
constexpr size_t WS_RGI = 28 * MiB + 256 * 1024;

struct Params {
    const float *x, *c; const int* pos;
    const float *w_mod, *b_mod, *g_mix, *w_in, *lq1, *lk1, *lq2, *lk2, *g_subln, *conv_rnn_w, *conv_rnn_b, *w_rg_a, *b_rg_a, *w_rg_i, *b_rg_i, *lam_rg, *w_out, *g_ffn, *w_up, *conv_ffn_w, *conv_ffn_b, *w_down, *g_final;
    float* out; unsigned char* ws; int ph_lo, ph_hi;
};


typedef __attribute__((address_space(4))) const unsigned char* kaptr_t;
template <class T> __device__ __forceinline__ T ka_load(kaptr_t ka, size_t off) { asm volatile("" : "+s"(ka)); return *(const __attribute__((address_space(4))) T*)(ka + off); }
#define PP(f) ka_load<decltype(Params::f)>(ka, offsetof(Params, f))
__device__ __forceinline__ int cur_tid(int wave0) { unsigned z = 0u; asm volatile("" : "+v"(z)); return wave0 * 64 + (int)__builtin_amdgcn_mbcnt_hi(~0u, __builtin_amdgcn_mbcnt_lo(~0u, z)); }
template <int CTRL> __device__ __forceinline__ float dpp_mov(float x) { return __int_as_float(__builtin_amdgcn_update_dpp(0, __float_as_int(x), CTRL, 0xf, 0xf, true)); }
__device__ __forceinline__ float rowsum16(float v) {
    v += dpp_mov<0x128>(v); v += dpp_mov<0x124>(v); v += dpp_mov<0x122>(v); v += dpp_mov<0x121>(v); return v; }
__device__ __forceinline__ float wsum64(float v) {
#pragma unroll
    for (int o = 1; o < 64; o <<= 1) v += __shfl_xor(v, o);
    return v;
}
__device__ __forceinline__ unsigned pkbf(float lo, float hi) { return pg8::cvt_pk_bf16(lo, hi); }
__device__ __forceinline__ float bflo(unsigned w) { return __uint_as_float(w << 16); }
__device__ __forceinline__ float bfhi(unsigned w) { return __uint_as_float(w & 0xffff0000u); }

template <int MAP> __device__ __forceinline__ int srccol(int n) {
    if (MAP == 0) return n;
    if (MAP == 1) {
        const int pn = n >> 8, p = n & 255;
        if (pn < 8) { const int bj = p >> 7, wc = (p >> 5) & 3, d = p & 31; return (pn >> 2) * 1024 + (4 * (pn & 3) + wc) * 64 + 32 * bj + d; }
        if (pn < 16) return n;
        if (pn < 24) return (p < 128 ? 4096 : 6144) + (pn - 16) * 128 + (p & 127);
        return 5120 + (pn - 24) * 256 + p;
    }
    if (MAP == 2) { const int pn = n >> 8, p = n & 255; return (p < 128 ? 0 : 3072) + pn * 128 + (p & 127); }
    return n;
}
constexpr int TR_LD = 68, TR_SCR_BYTES = 64 * TR_LD * 4;
template <int MAP> __device__ __forceinline__ void transpose_item(const float* __restrict__ W, int K, int ldw, int ndest, bf16* WT, LAS float* scr, int item, int lane) {
    const int nblk = ndest / 64, kb = item / nblk, nb = item % nblk, k0 = 64 * kb, n0 = 64 * nb;
    const int c4 = lane & 15, kr = lane >> 4;
    const int sc = srccol<MAP>(n0 + 4 * c4);
    f32x4 v[16];
#pragma unroll
    for (int i = 0; i < 16; ++i) v[i] = *(const f32x4*)(W + (size_t)(k0 + 4 * i + kr) * ldw + sc);
#pragma unroll
    for (int i = 0; i < 16; ++i) { const int k = 4 * i + kr; *(LAS f32x4*)(scr + k * TR_LD + ((4 * c4 + 4 * (k >> 3)) & 63)) = v[i]; }
    asm volatile("s_waitcnt lgkmcnt(0)" ::: "memory");
    const int c = lane & 7;
#pragma unroll
    for (int j = 0; j < 8; ++j) { const int n = (lane >> 3) + 8 * j; const LAS float* s = scr + (8 * c) * TR_LD + ((n + 4 * c) & 63);
        v4u o; o.x = pkbf(s[0 * TR_LD], s[1 * TR_LD]); o.y = pkbf(s[2 * TR_LD], s[3 * TR_LD]); o.z = pkbf(s[4 * TR_LD], s[5 * TR_LD]); o.w = pkbf(s[6 * TR_LD], s[7 * TR_LD]);
        *(v4u*)(WT + (size_t)(n0 + n) * K + k0 + 8 * c) = o; }
    asm volatile("s_waitcnt lgkmcnt(0)" ::: "memory");
}
template <int MAP> __device__ __forceinline__ int convert_w(const float* W, int K, int ldw, int ndest, bf16* WT, LAS float* scr, int gw, int NGW, int base, int lane) {
    const int nitems = (K / 64) * (ndest / 64);
    int first = (gw - base % NGW + NGW) % NGW;
    for (int it = first; it < nitems; it += NGW) transpose_item<MAP>(W, K, ldw, ndest, WT, scr, it, lane);
    return base + nitems;
}
__device__ __forceinline__ void bias_rows(const bf16* WT, int nrows, const float* sh0, const float* sh1, float* bias, int ldb, int gw, int NGW, int lane) {
    f32x4 a0[4], a1[4];
#pragma unroll
    for (int j = 0; j < 4; ++j) { a0[j] = *(const f32x4*)(sh0 + lane * 16 + 4 * j); a1[j] = *(const f32x4*)(sh1 + lane * 16 + 4 * j); }
    for (int n0 = gw; n0 < nrows; n0 += 4 * NGW) {
        v4u w0[4], w1[4];
#pragma unroll
        for (int q = 0; q < 4; ++q) { const int n = min(n0 + q * NGW, nrows - 1); w0[q] = *(const v4u*)(WT + (size_t)n * 1024 + lane * 16); w1[q] = *(const v4u*)(WT + (size_t)n * 1024 + lane * 16 + 8); }
#pragma unroll
        for (int q = 0; q < 4; ++q) {
            const int n = n0 + q * NGW;
            float s0 = 0.f, s1 = 0.f;
#pragma unroll
            for (int e = 0; e < 4; ++e) {
                const float wl = bflo(w0[q][e]), wh = bfhi(w0[q][e]), xl = bflo(w1[q][e]), xh = bfhi(w1[q][e]);
                s0 += wl * a0[e >> 1][(e & 1) * 2] + wh * a0[e >> 1][(e & 1) * 2 + 1] + xl * a0[2 + (e >> 1)][(e & 1) * 2] + xh * a0[2 + (e >> 1)][(e & 1) * 2 + 1];
                s1 += wl * a1[e >> 1][(e & 1) * 2] + wh * a1[e >> 1][(e & 1) * 2 + 1] + xl * a1[2 + (e >> 1)][(e & 1) * 2] + xh * a1[2 + (e >> 1)][(e & 1) * 2 + 1];
            }
            s0 = wsum64(s0); s1 = wsum64(s1);
            if (lane == 0 && n < nrows) { bias[n] = s0; bias[ldb + n] = s1; }
        }
    }
}

constexpr int RT_LD = 136, RT_B = 69632, RT_COMP = 139264, RT_HIN = 147456, RT_FOLD = 151552, RT_END = 155648;
__device__ __forceinline__ void rnn_stage_w(kaptr_t ka, int n, LAS unsigned char* lds, int tid) {
    const bf16* wa = (const bf16*)(PP(ws) + WS_RGA) + (size_t)n * 16384; const bf16* wi = (const bf16*)(PP(ws) + WS_RGI) + (size_t)n * 16384;
    LAS bf16* Bt = (LAS bf16*)(lds + RT_B);
    v4u v[8];
#pragma unroll
    for (int i = 0; i < 8; ++i) { const int it = tid + i * NTHREADS, row = it >> 4, cg = (it & 15) * 8; v[i] = *(const v4u*)((row < 128 ? wa : wi) + (size_t)(row & 127) * 128 + cg); }
#pragma unroll
    for (int i = 0; i < 8; ++i) { const int it = tid + i * NTHREADS, row = it >> 4, cg = (it & 15) * 8; *(LAS v4u*)(Bt + row * RT_LD + cg) = v[i]; }
}
template <bool PASS2> __device__ __forceinline__ void rnn_tile(kaptr_t ka, int l, int rt, int n, LAS unsigned char* lds, int tid, int wave, int lane,
                                                               const bf16* XR, const bf16* O, const bf16* SGA, const bf16* G2, bf16* MIX, float lam_os) {
    const int b = rt >> 5, t0 = (rt & 31) * 256; const size_t row0 = (size_t)rt * 256;
    LAS bf16* At = (LAS bf16*)lds; LAS bf16* Bt = (LAS bf16*)(lds + RT_B);
    {
        const float* cw = PP(conv_rnn_w) + (size_t)l * 4 * 1024 + n * 128; const float* cb = PP(conv_rnn_b) + l * 1024 + n * 128;
        const int cg = (tid & 15) * 8, r0 = (tid >> 4) * 8;
        v4u xv[11];
#pragma unroll
        for (int j = 0; j < 11; ++j) { const int tt = t0 + r0 - 3 + j; xv[j] = tt >= 0 ? *(const v4u*)(XR + (row0 + r0 - 3 + j) * 1024 + n * 128 + cg) : (v4u){0u, 0u, 0u, 0u}; }
        float w[4][8], bb[8];
#pragma unroll
        for (int j = 0; j < 4; ++j) { const f32x4 w0 = *(const f32x4*)(cw + j * 1024 + cg), w1 = *(const f32x4*)(cw + j * 1024 + cg + 4);
#pragma unroll
            for (int e = 0; e < 4; ++e) { w[j][e] = w0[e]; w[j][4 + e] = w1[e]; } }
        { const f32x4 b0 = *(const f32x4*)(cb + cg), b1 = *(const f32x4*)(cb + cg + 4);
#pragma unroll
          for (int e = 0; e < 4; ++e) { bb[e] = b0[e]; bb[4 + e] = b1[e]; } }
#pragma unroll
        for (int r = 0; r < 8; ++r) {
            float acc[8];
#pragma unroll
            for (int e = 0; e < 8; ++e) acc[e] = bb[e];
#pragma unroll
            for (int j = 0; j < 4; ++j) { const v4u x = xv[r + j];
                acc[0] += w[j][0] * bflo(x.x); acc[1] += w[j][1] * bfhi(x.x); acc[2] += w[j][2] * bflo(x.y); acc[3] += w[j][3] * bfhi(x.y);
                acc[4] += w[j][4] * bflo(x.z); acc[5] += w[j][5] * bfhi(x.z); acc[6] += w[j][6] * bflo(x.w); acc[7] += w[j][7] * bfhi(x.w); }
            v4u o; o.x = pkbf(acc[0], acc[1]); o.y = pkbf(acc[2], acc[3]); o.z = pkbf(acc[4], acc[5]); o.w = pkbf(acc[6], acc[7]);
            *(LAS v4u*)(At + (r0 + r) * RT_LD + cg) = o;
        }
    }
    __syncthreads();
    float nba_[4], nbi_[4], sp8l_[4];
#pragma unroll
    for (int cbk = 0; cbk < 4; ++cbk) { const int ch = l * 1024 + n * 128 + cbk * 32 + (lane & 31);
        const float lr = PP(lam_rg)[ch];
        nba_[cbk] = -1.4426950408889634f * PP(b_rg_a)[ch]; nbi_[cbk] = -1.4426950408889634f * PP(b_rg_i)[ch];
        sp8l_[cbk] = -8.0f * 1.4426950408889634f * ((lr > 0.f ? 0.f : -lr) + log1pf(__expf(-fabsf(lr)))); }
    f32x16 R[4], I[4];
    { const int r32 = lane & 31, hi = lane >> 5;
#pragma unroll
    for (int cbk = 0; cbk < 4; ++cbk) { R[cbk] = f32x16{}; I[cbk] = f32x16{}; }
#pragma unroll
    for (int s = 0; s < 8; ++s) {
        const bf16x8 af = *(const LAS bf16x8*)(At + (wave * 32 + r32) * RT_LD + 16 * s + 8 * hi);
#pragma unroll
        for (int cbk = 0; cbk < 4; ++cbk) {
            const bf16x8 ba = *(const LAS bf16x8*)(Bt + (cbk * 32 + r32) * RT_LD + 16 * s + 8 * hi);
            const bf16x8 bi = *(const LAS bf16x8*)(Bt + (128 + cbk * 32 + r32) * RT_LD + 16 * s + 8 * hi);
            R[cbk] = __builtin_amdgcn_mfma_f32_32x32x16_bf16(af, ba, R[cbk], 0, 0, 0);
            I[cbk] = __builtin_amdgcn_mfma_f32_32x32x16_bf16(af, bi, I[cbk], 0, 0, 0);
        }
    } }
    int ln3 = tid; asm volatile("" : "+v"(ln3)); const int r32 = ln3 & 31, hi = (ln3 >> 5) & 1;
    LAS float* comp = (LAS float*)(lds + RT_COMP); LAS float* hin = (LAS float*)(lds + RT_HIN); LAS float* fold = (LAS float*)(lds + RT_FOLD);
#pragma unroll
    for (int cbk = 0; cbk < 4; ++cbk) {
        const float nba = nba_[cbk], nbi = nbi_[cbk], sp8l = sp8l_[cbk];
        float pc = 1.f, sc = 0.f;
#pragma unroll
        for (int q = 0; q < 4; ++q) {
            float pp = 1.f, ss = 0.f;
#pragma unroll
            for (int e = 0; e < 4; ++e) {
                const int reg = 4 * q + e, srow = wave * 32 + e + 8 * q + 4 * hi;
                const float xc = __uint_as_float(((unsigned)At[srow * RT_LD + cbk * 32 + r32]) << 16);
                const float rg = __builtin_amdgcn_rcpf(1.0f + __builtin_amdgcn_exp2f(fmaf(R[cbk][reg], -1.4426950408889634f, nba)));
                const float ig = __builtin_amdgcn_rcpf(1.0f + __builtin_amdgcn_exp2f(fmaf(I[cbk][reg], -1.4426950408889634f, nbi)));
                const float a = __builtin_amdgcn_exp2f(sp8l * rg);
                const float uu = __builtin_amdgcn_sqrtf(fmaf(-a, a, 1.0f)) * (ig * xc);
                R[cbk][reg] = a; I[cbk][reg] = uu;
                pp *= a; ss = ss * a + uu;
            }
            const auto rp = __builtin_amdgcn_permlane32_swap(__float_as_uint(pp), __float_as_uint(pp), false, false);
            const auto rs = __builtin_amdgcn_permlane32_swap(__float_as_uint(ss), __float_as_uint(ss), false, false);
            sc = sc * __uint_as_float(rp[0]) + __uint_as_float(rs[0]); pc *= __uint_as_float(rp[0]);
            sc = sc * __uint_as_float(rp[1]) + __uint_as_float(rs[1]); pc *= __uint_as_float(rp[1]);
        }
        if (hi == 0) { comp[(wave * 128 + cbk * 32 + r32) * 2] = pc; comp[(wave * 128 + cbk * 32 + r32) * 2 + 1] = sc; }
    }
    unsigned long long* agg = (unsigned long long*)(PP(ws) + WS_AGG);
    unsigned* rfl = (unsigned*)(PP(ws) + WS_RFLAGS) + l * 512;
    __syncthreads();
    if (tid < 128) {
        float pc = 1.f, sc = 0.f;
#pragma unroll
        for (int s = 0; s < 8; ++s) { const float p = comp[(s * 128 + tid) * 2], q = comp[(s * 128 + tid) * 2 + 1]; sc = sc * p + q; pc *= p; }
        __hip_atomic_store(agg + (size_t)rt * 1024 + n * 128 + tid, ((unsigned long long)__float_as_uint(sc) << 32) | __float_as_uint(pc), __ATOMIC_RELAXED, __HIP_MEMORY_SCOPE_AGENT);
    }
    asm volatile("s_waitcnt vmcnt(0)" ::: "memory");
    __syncthreads();
    if (tid == 0) __hip_atomic_store(rfl + rt * 8 + n, 1u, __ATOMIC_RELAXED, __HIP_MEMORY_SCOPE_AGENT);
    if (tid < 32 && b * 32 + tid < rt) { unsigned spins = 0; while (__hip_atomic_load(rfl + (b * 32 + tid) * 8 + n, __ATOMIC_RELAXED, __HIP_MEMORY_SCOPE_AGENT) == 0u && ++spins < (1u << 22)) __builtin_amdgcn_s_sleep(2); }
    __syncthreads();
    {
        const int ch = tid & 127, p = tid >> 7, rbase = b * 32 + 8 * p;
        unsigned long long a2[8];
#pragma unroll
        for (int j = 0; j < 8; ++j) a2[j] = (rbase + j < rt) ? __hip_atomic_load(agg + (size_t)(rbase + j) * 1024 + n * 128 + ch, __ATOMIC_RELAXED, __HIP_MEMORY_SCOPE_AGENT) : 0x000000003f800000ull;
        float pp = 1.f, ss = 0.f;
#pragma unroll
        for (int j = 0; j < 8; ++j) { const float px = __uint_as_float((unsigned)a2[j]), sx = __uint_as_float((unsigned)(a2[j] >> 32)); ss = ss * px + sx; pp *= px; }
        fold[(p * 128 + ch) * 2] = pp; fold[(p * 128 + ch) * 2 + 1] = ss;
    }
    __syncthreads();
    if (tid < 128) {
        float h = 0.f;
#pragma unroll
        for (int p = 0; p < 4; ++p) h = h * fold[(p * 128 + tid) * 2] + fold[(p * 128 + tid) * 2 + 1];
#pragma unroll
        for (int s = 0; s < 8; ++s) { hin[s * 128 + tid] = h; h = h * comp[(s * 128 + tid) * 2] + comp[(s * 128 + tid) * 2 + 1]; }
    }
    __syncthreads();
#pragma unroll
    for (int cbk = 0; cbk < 4; ++cbk) {
        float hs = hin[wave * 128 + cbk * 32 + r32];
#pragma unroll
        for (int q = 0; q < 4; ++q) {
            float pp = 1.f, ss = 0.f, hh;
            float hv[4];
#pragma unroll
            for (int e = 0; e < 4; ++e) { const float a = R[cbk][4 * q + e], uu = I[cbk][4 * q + e]; pp *= a; ss = ss * a + uu; }
            const auto rp = __builtin_amdgcn_permlane32_swap(__float_as_uint(pp), __float_as_uint(pp), false, false);
            const auto rs = __builtin_amdgcn_permlane32_swap(__float_as_uint(ss), __float_as_uint(ss), false, false);
            const float p0 = __uint_as_float(rp[0]), p1 = __uint_as_float(rp[1]), s0 = __uint_as_float(rs[0]), s1 = __uint_as_float(rs[1]);
            const float h_mid = hs * p0 + s0;
            hh = hi ? h_mid : hs;
#pragma unroll
            for (int e = 0; e < 4; ++e) { hh = hh * R[cbk][4 * q + e] + I[cbk][4 * q + e]; hv[e] = hh; }
            hs = h_mid * p1 + s1;
#pragma unroll
            for (int e = 0; e < 4; ++e) { const int srow = wave * 32 + e + 8 * q + 4 * hi; At[srow * RT_LD + cbk * 32 + r32] = (bf16)(pkbf(hv[e], 0.f) & 0xffffu); }
        }
    }
    __syncthreads();
    const float* gs = PP(g_subln) + l * 128;
    const int cg = (tid & 15) * 8;
    const f32x4 g0 = *(const f32x4*)(gs + cg), g1 = *(const f32x4*)(gs + cg + 4);
    const float gsv[8] = {g0[0], g0[1], g0[2], g0[3], g1[0], g1[1], g1[2], g1[3]};
    v4u ovB[8], avB[8], gvB[8];
#pragma unroll
    for (int i = 0; i < 8; ++i) { const int r = (tid >> 4) + 32 * i; const size_t off = (row0 + r) * 1024 + n * 128 + cg;
        ovB[i] = *(const v4u*)(O + off); avB[i] = *(const v4u*)(SGA + off); gvB[i] = *(const v4u*)(G2 + off); }
#pragma unroll
    for (int bt = 0; bt < 2; ++bt) {
#pragma unroll
        for (int i = 0; i < 4; ++i) {
            const v4u ovi = ovB[bt * 4 + i], avi = avB[bt * 4 + i], gvi = gvB[bt * 4 + i];
            const int r = (tid >> 4) + 32 * (bt * 4 + i); const size_t off = (row0 + r) * 1024 + n * 128 + cg;
            const v4u hv = *(const LAS v4u*)(At + r * RT_LD + cg);
            const float o[8] = {bflo(ovi.x), bfhi(ovi.x), bflo(ovi.y), bfhi(ovi.y), bflo(ovi.z), bfhi(ovi.z), bflo(ovi.w), bfhi(ovi.w)};
            float ss = 0.f;
#pragma unroll
            for (int e = 0; e < 8; ++e) ss += o[e] * o[e];
            ss = rowsum16(ss);
            const float rn = __builtin_amdgcn_rsqf(ss * (1.f / 128.f) + 1e-6f) * lam_os;
            const float a[8] = {bflo(avi.x), bfhi(avi.x), bflo(avi.y), bfhi(avi.y), bflo(avi.z), bfhi(avi.z), bflo(avi.w), bfhi(avi.w)};
            const float g[8] = {bflo(gvi.x), bfhi(gvi.x), bflo(gvi.y), bfhi(gvi.y), bflo(gvi.z), bfhi(gvi.z), bflo(gvi.w), bfhi(gvi.w)};
            const float h[8] = {bflo(hv.x), bfhi(hv.x), bflo(hv.y), bfhi(hv.y), bflo(hv.z), bfhi(hv.z), bflo(hv.w), bfhi(hv.w)};
            float m[8];
#pragma unroll
            for (int e = 0; e < 8; ++e) m[e] = a[e] * (o[e] * rn * gsv[e]) + g[e] * h[e];
            v4u w; w.x = pkbf(m[0], m[1]); w.y = pkbf(m[2], m[3]); w.z = pkbf(m[4], m[5]); w.w = pkbf(m[6], m[7]);
            *(v4u*)(MIX + off) = w;
        }
    }
    __syncthreads();
}

__device__ __forceinline__ void act_pass(kaptr_t ka, int l, int b, const bf16* U, bf16* ACT, int gtid, int NT) {
    const float* cw = PP(conv_ffn_w) + (size_t)l * 3 * 6144; const float* cbp = PP(conv_ffn_b) + l * 6144;
    for (int it = gtid; it < 8192 * 384; it += NT) {
        const int t = it / 384, cg = (it % 384) * 8;
        float val[8], gate[8];
        { const f32x4 b0 = *(const f32x4*)(cbp + cg), b1 = *(const f32x4*)(cbp + cg + 4), c0 = *(const f32x4*)(cbp + 3072 + cg), c1 = *(const f32x4*)(cbp + 3072 + cg + 4);
#pragma unroll
          for (int e = 0; e < 4; ++e) { val[e] = b0[e]; val[4 + e] = b1[e]; gate[e] = c0[e]; gate[4 + e] = c1[e]; } }
#pragma unroll
        for (int j = 0; j < 3; ++j) {
            const int ts = t - 2 + j;
            if (ts >= 0) {
                const v4u uv = *(const v4u*)(U + (size_t)ts * 6144 + cg), ug = *(const v4u*)(U + (size_t)ts * 6144 + 3072 + cg);
                const f32x4 w0 = *(const f32x4*)(cw + j * 6144 + cg), w1 = *(const f32x4*)(cw + j * 6144 + cg + 4), x0 = *(const f32x4*)(cw + j * 6144 + 3072 + cg), x1 = *(const f32x4*)(cw + j * 6144 + 3072 + cg + 4);
                val[0] += w0[0] * bflo(uv.x); val[1] += w0[1] * bfhi(uv.x); val[2] += w0[2] * bflo(uv.y); val[3] += w0[3] * bfhi(uv.y);
                val[4] += w1[0] * bflo(uv.z); val[5] += w1[1] * bfhi(uv.z); val[6] += w1[2] * bflo(uv.w); val[7] += w1[3] * bfhi(uv.w);
                gate[0] += x0[0] * bflo(ug.x); gate[1] += x0[1] * bfhi(ug.x); gate[2] += x0[2] * bflo(ug.y); gate[3] += x0[3] * bfhi(ug.y);
                gate[4] += x1[0] * bflo(ug.z); gate[5] += x1[1] * bfhi(ug.z); gate[6] += x1[2] * bflo(ug.w); gate[7] += x1[3] * bfhi(ug.w);
            }
        }
        float r[8];
#pragma unroll
        for (int e = 0; e < 8; ++e) r[e] = pg8::fast_gelu(gate[e]) * val[e];
        v4u w; w.x = pkbf(r[0], r[1]); w.y = pkbf(r[2], r[3]); w.z = pkbf(r[4], r[5]); w.w = pkbf(r[6], r[7]);
        *(v4u*)(ACT + ((size_t)b * 8192 + t) * 3072 + cg) = w;
    }
}

#ifndef STAG_GRP
#define STAG_GRP ((bx >> 3) & 3)
#endif
#ifndef STAG_A
#define STAG_A 0
#endif
#ifndef REP_A
#define REP_A 1
#endif
#ifndef REP_ATT
#define REP_ATT 1
#endif
#ifndef REP_RNN1
#define REP_RNN1 1
#endif
#ifndef REP_D
#define REP_D 1
#endif
#ifndef REP_F
#define REP_F 1
#endif
#ifndef REP_ACT
#define REP_ACT 1
#endif
#ifndef REP_P0
#define REP_P0 1
#endif
constexpr int N_PHASES = 14;
__global__ void __launch_bounds__(NTHREADS, 2) mk_fwd(Params P) {
    extern __shared__ __attribute__((aligned(16))) unsigned char lds_raw[];
    LAS unsigned char* lds = (LAS unsigned char*)lds_raw;
    volatile LAS unsigned* MISC = (volatile LAS unsigned*)(lds + LDS_MISC);
    const int wave0 = __builtin_amdgcn_readfirstlane((int)threadIdx.x >> 6);
#define CUR_TID() cur_tid(wave0)
    const int G = gridDim.x, bx = blockIdx.x, vcu = (G % 8 == 0) ? (bx % 8) * (G / 8) + bx / 8 : bx;
    const int NGW = G * NWAVES;
#define PHASE_IDS() int tid = CUR_TID(); asm volatile("" : "+v"(tid)); const int lane = tid & 63, wave = __builtin_amdgcn_readfirstlane(tid >> 6), gw = vcu * NWAVES + wave; LAS float* scr = (LAS float*)(lds + wave * TR_SCR_BYTES); (void)lane; (void)gw; (void)scr
    const kaptr_t ka = (kaptr_t)__builtin_amdgcn_kernarg_segment_ptr();
    gu32* ctl = (gu32*)PP(ws);
    for (int u = (int)threadIdx.x; u < (LDS_BYTES - LDS_CTL0) / 4; u += NTHREADS) ((LAS unsigned*)(lds + LDS_CTL0))[u] = 0u;
    __syncthreads();
    const int lo = PP(ph_lo), hi = PP(ph_hi);
    const bool multi = (hi - lo) > 1;
    XcdBarrier bar; bar.bar = (unsigned*)(ctl + CW_BAR); bar.x = 0; bar.st = nullptr;
    if (multi) bar = xcd_barrier_post((unsigned*)(ctl + CW_BAR), MISC + 8);
#define IN(k) (lo <= (k) && (k) < hi)
#define SEAM(k) do { if (IN(k) && IN((k) + 1)) xcd_barrier(bar); } while (0)

#define WS_PTRS() unsigned char* ws = PP(ws); \
    float* mod = (float*)(ws + WS_MOD); float* lamv = (float*)(ws + WS_LAM); float* cs = (float*)(ws + WS_COS); float* sn = (float*)(ws + WS_SIN); \
    bf16* S1 = (bf16*)(ws + 1 * SLOT); bf16* S2 = (bf16*)(ws + 2 * SLOT); bf16* S5 = (bf16*)(ws + 5 * SLOT); bf16* S6 = (bf16*)(ws + 6 * SLOT); bf16* S7 = (bf16*)(ws + 7 * SLOT); \
    bf16* WA = (bf16*)(ws + WS_WA); bf16* WOUT = (bf16*)(ws + WS_WOUT); bf16* WDOWN = (bf16*)(ws + WS_WDOWN); \
    float* rss0 = (float*)(ws + WS_RSS0); float* bias_in = (float*)(ws + WS_BIASIN); float* bias_up = (float*)(ws + WS_BIASUP); \
    const float* md = mod + (size_t)l * 2 * 6144; float* rssA = (float*)(ws + WS_RSS) + (size_t)(l * 2 + 0) * M; float* rssB = (float*)(ws + WS_RSS) + (size_t)(l * 2 + 1) * M; \
    const float* rss_in = l == 0 ? rss0 : (float*)(ws + WS_RSS) + (size_t)1 * M; const float* xin = l == 0 ? PP(x) : PP(out); \
    (void)mod; (void)lamv; (void)cs; (void)sn; (void)S1; (void)S2; (void)S5; (void)S6; (void)S7; (void)WA; (void)WOUT; (void)WDOWN; (void)rss0; (void)bias_in; (void)bias_up; (void)md; (void)rssA; (void)rssB; (void)rss_in; (void)xin

    if (IN(0)) {
        PHASE_IDS(); const int l = 0; WS_PTRS();
        for (int task = gw; task < 1536; task += NGW) {
            const int l = task / 768, rem = task % 768, chunk = rem >> 3, ks = rem & 7, n = chunk * 64 + lane;
            const float* w = PP(w_mod) + (size_t)l * 1024 * 6144 + (size_t)(ks * 128) * 6144 + n;
            float a0 = 0.f, a1 = 0.f;
            float sl[2][2];
#pragma unroll
            for (int bb = 0; bb < 2; ++bb)
#pragma unroll
                for (int hh = 0; hh < 2; ++hh) { const float cv = PP(c)[bb * 1024 + ks * 128 + hh * 64 + lane]; sl[bb][hh] = cv * __builtin_amdgcn_rcpf(1.f + __expf(-cv)); }
#pragma unroll
            for (int hh = 0; hh < 2; ++hh) {
#pragma unroll
                for (int k = 0; k < 64; ++k) { const float wv = w[(size_t)(hh * 64 + k) * 6144];
                    a0 += __builtin_bit_cast(float, __builtin_amdgcn_readlane(__builtin_bit_cast(int, sl[0][hh]), k)) * wv; a1 += __builtin_bit_cast(float, __builtin_amdgcn_readlane(__builtin_bit_cast(int, sl[1][hh]), k)) * wv; }
            }
            if (ks == 0) { const float bm = PP(b_mod)[l * 6144 + n]; a0 += bm; a1 += bm; }
            atomicAdd(mod + (size_t)(l * 2 + 0) * 6144 + n, a0); atomicAdd(mod + (size_t)(l * 2 + 1) * 6144 + n, a1);
        }
        if (gw == 0 && lane < 2) {
            const int l = lane; float s1 = 0.f, s2 = 0.f;
            for (int i = 0; i < 64; ++i) { s1 += PP(lq1)[l * 64 + i] * PP(lk1)[l * 64 + i]; s2 += PP(lq2)[l * 64 + i] * PP(lk2)[l * 64 + i]; }
            lamv[l] = expf(s1) - expf(s2) + (0.8f - 0.6f * expf(-0.3f * (float)l));
        }
        for (int idx = gw * 64 + lane; idx < M * 32; idx += NGW * 64) {
            const int row = idx >> 5, i = idx & 31;
            const float inv = (float)exp(-(double)i * (9.210340371976184 / 32.0));
            const float ang = (float)PP(pos)[row] * inv;
            const double a = (double)ang, k = rint(a * 0.15915494309189535);
            const float rf = (float)(fma(-k, 6.283185307179586, a) - k * 2.4492935982947064e-16);
            cs[idx] = __cosf(rf); sn[idx] = __sinf(rf);
        }
        int base = 0;
        base = convert_w<1>(PP(w_in), 1024, NIN, NIN, WA, scr, gw, NGW, base, lane);
        base = convert_w<0>(PP(w_out), 1024, 1024, 1024, WOUT, scr, gw, NGW, base, lane);
        base = convert_w<0>(PP(w_down), 3072, 1024, 1024, WDOWN, scr, gw, NGW, base, lane);
        for (int nb = 0; nb < 8; ++nb) {
            base = convert_w<0>(PP(w_rg_a) + (size_t)nb * 16384, 128, 128, 128, (bf16*)(ws + WS_RGA) + (size_t)nb * 16384, scr, gw, NGW, base, lane);
            base = convert_w<0>(PP(w_rg_i) + (size_t)nb * 16384, 128, 128, 128, (bf16*)(ws + WS_RGI) + (size_t)nb * 16384, scr, gw, NGW, base, lane);
        }
    }
    SEAM(0);
    if (IN(1)) {
        PHASE_IDS(); const int l = 0; WS_PTRS();
        const float* g = PP(g_mix);
        for (int row0 = gw; row0 < M; row0 += 4 * NGW) {
            f32x4 v[4][4];
#pragma unroll
            for (int q = 0; q < 4; ++q) { const f32x4* xr = (const f32x4*)(PP(x) + (size_t)(row0 + q * NGW) * 1024) + lane;
#pragma unroll
                for (int j = 0; j < 4; ++j) v[q][j] = xr[64 * j]; }
#pragma unroll
            for (int q = 0; q < 4; ++q) {
                const int row = row0 + q * NGW, b = row >> 13; const float* sc = mod + (size_t)b * 6144 + 1024;
                float s = 0.f;
#pragma unroll
                for (int j = 0; j < 4; ++j) s += (v[q][j][0] * v[q][j][0] + v[q][j][1] * v[q][j][1]) + (v[q][j][2] * v[q][j][2] + v[q][j][3] * v[q][j][3]);
                s = wsum64(s);
                if (lane == 0) rss0[row] = s;
#pragma unroll
                for (int j = 0; j < 4; ++j) { const int k = (lane + 64 * j) * 4; const f32x4 gm = *(const f32x4*)(g + k) * (*(const f32x4*)(sc + k) + 1.0f); const f32x4 a = v[q][j] * gm;
                    v2u w; w.x = pkbf(a[0], a[1]); w.y = pkbf(a[2], a[3]); *(v2u*)(S1 + (size_t)row * 1024 + k) = w; }
            }
        }
        bias_rows(WA, NIN, mod + 0, mod + 6144, bias_in, 7168, gw, NGW, lane);
    }
    SEAM(1);

    for (int l = 0; l < 2; ++l) {
        const int pb = 2 + 6 * l;
        if (IN(pb + 0)) {
            WS_PTRS();
            pg8::Gemm g{S1, WA, M, NIN, 1024}; pg8::StaticOrder S; S.init(M, NIN, G, bx);
            pg8::EpiIn E{S2, cs, sn, rss_in, bias_in};
#if STAG_A > 0
            { const int grp = STAG_GRP; if (grp) { const unsigned long long t0 = __builtin_amdgcn_s_memrealtime(); while (__builtin_amdgcn_s_memrealtime() - t0 < (unsigned long long)(grp * STAG_A)) __builtin_amdgcn_s_sleep(8); } }
#endif
            for (int rep = 0; rep < REP_A; ++rep) pg8::gemm_phase<pg8::EpiIn, pg8::StaticOrder, true, true>(lds, g, S, E, CUR_TID());
        }
        SEAM(pb + 0);
        if (IN(pb + 1)) {
            PHASE_IDS(); WS_PTRS();
            if (G == 256) {
#pragma unroll 1
                for (int i = 0; i < 4 * REP_ATT; ++i) {
                    const int bh = vcu >> 4, b = bh >> 3, h = bh & 7, s = vcu & 15;
                    const int qb = (i & 2) ? s : 31 - s, c = i & 1, hm = 2 * h + c;
                    const float lam = c ? lamv[l] : 0.f;
                    const attn_body::bf16* sb = (const attn_body::bf16*)(ws + SLOT);
                    constexpr size_t SE = SLOT / 2;
                    attn_body::attn_unit<8>(b, 0, qb, sb + SE + hm * 64, sb + 2 * SE + hm * 64, sb + 3 * SE + h * 128, (attn_body::bf16*)sb + h * 128, (char*)lds_raw, c == 1, lam, CUR_TID());
                }
            }
        }
        SEAM(pb + 1);
        if (IN(pb + 2)) {
            PHASE_IDS(); WS_PTRS();
            const float lam_os = 1.0f - (0.8f - 0.6f * expf(-0.3f * (float)l));
            rnn_stage_w(ka, vcu & 7, lds, tid);
            for (int rep = 0; rep < REP_D; ++rep) for (int t = vcu; t < 512; t += G) rnn_tile<true>(ka, l, t >> 3, t & 7, lds, tid, wave, lane, S5, S1, S6, S7, S2, lam_os);
            { int t2_ = CUR_TID(); asm volatile("" : "+v"(t2_)); const int lane_ = t2_ & 63, wave_ = __builtin_amdgcn_readfirstlane(t2_ >> 6), gw_ = vcu * NWAVES + wave_; LAS float* scr_ = (LAS float*)(lds + wave_ * TR_SCR_BYTES);
              bf16* S3 = (bf16*)(ws + 3 * SLOT);
              int base = 0;
              base = convert_w<2>(PP(w_up) + (size_t)l * 1024 * NUP, 1024, NUP, NUP, S3, scr_, gw_, NGW, base, lane_);
              if (l == 0) base = convert_w<1>(PP(w_in) + (size_t)1024 * NIN, 1024, NIN, NIN, WA, scr_, gw_, NGW, base, lane_);
              if (l == 1) base = convert_w<0>(PP(w_down) + (size_t)3072 * 1024, 3072, 1024, 1024, WDOWN, scr_, gw_, NGW, base, lane_); }
        }
        SEAM(pb + 2);
        if (IN(pb + 3)) {
            PHASE_IDS(); WS_PTRS();
            { pg8::Gemm g{S2, WOUT, M, 1024, 1024}; pg8::StaticOrder S; S.init(M, 1024, G, bx);
              pg8::EpiRes E{xin, PP(out), md + 2048, PP(g_ffn) + l * 1024, md + 4096, S1, rssA};
              pg8::gemm_phase<pg8::EpiRes, pg8::StaticOrder, true, true>(lds, g, S, E, CUR_TID()); }
            { int t2_ = CUR_TID(); asm volatile("" : "+v"(t2_)); const int lane_ = t2_ & 63, gw_ = vcu * NWAVES + __builtin_amdgcn_readfirstlane(t2_ >> 6);
              bias_rows((const bf16*)(ws + 3 * SLOT), NUP, md + 3072, md + 6144 + 3072, bias_up, 6144, gw_, NGW, lane_);
              if (l == 0) bias_rows(WA, NIN, mod + 2 * 6144, mod + 3 * 6144, bias_in, 7168, gw_, NGW, lane_); }
        }
        SEAM(pb + 3);
        if (IN(pb + 4)) {
            WS_PTRS();
            { pg8::Gemm g{S1, (const bf16*)(ws + 3 * SLOT), M, NUP, 1024}; pg8::StaticOrder S; S.init(M, NUP, G, bx);
              pg8::EpiUpConv E{S5, rssA, bias_up, PP(conv_ffn_w) + (size_t)l * 3 * NUP, PP(conv_ffn_b) + l * NUP, (float*)S2, (unsigned*)(ws + WS_FLAGS) + l * 1536, (PG8_LAS float*)(lds + 131072)};
#ifdef STAG_F
              { const int grp = (bx >> 6); if (grp) { const unsigned long long t0 = __builtin_amdgcn_s_memrealtime(); while (__builtin_amdgcn_s_memrealtime() - t0 < (unsigned long long)(grp * STAG_F)) __builtin_amdgcn_s_sleep(8); } }
#endif
              for (int rep = 0; rep < REP_F; ++rep) pg8::gemm_phase<pg8::EpiUpConv, pg8::StaticOrder, true, true>(lds, g, S, E, CUR_TID()); }
            if (l == 0) { int t2_ = CUR_TID(); asm volatile("" : "+v"(t2_)); const int lane_ = t2_ & 63, wave_ = __builtin_amdgcn_readfirstlane(t2_ >> 6), gw_ = vcu * NWAVES + wave_; LAS float* scr_ = (LAS float*)(lds + wave_ * TR_SCR_BYTES);
                int base = 0;
                base = convert_w<0>(PP(w_out) + (size_t)1024 * 1024, 1024, 1024, 1024, WOUT, scr_, gw_, NGW, base, lane_);
                for (int nb = 0; nb < 8; ++nb) {
                    base = convert_w<0>(PP(w_rg_a) + (size_t)(8 + nb) * 16384, 128, 128, 128, (bf16*)(ws + WS_RGA) + (size_t)nb * 16384, scr_, gw_, NGW, base, lane_);
                    base = convert_w<0>(PP(w_rg_i) + (size_t)(8 + nb) * 16384, 128, 128, 128, (bf16*)(ws + WS_RGI) + (size_t)nb * 16384, scr_, gw_, NGW, base, lane_);
                }
            }
        }
        SEAM(pb + 4);
        if (IN(pb + 5)) {
            PHASE_IDS(); WS_PTRS();
            if (l == 0) { pg8::Gemm g{S5, WDOWN, M, 1024, 3072}; pg8::StaticOrder S; S.init(M, 1024, G, bx);
              pg8::EpiRes E{PP(out), PP(out), md + 5120, PP(g_mix) + 1024, mod + 2 * 6144 + 1024, S1, rssB};
              pg8::gemm_phase<pg8::EpiRes, pg8::StaticOrder, true, true>(lds, g, S, E, CUR_TID()); }
            else { pg8::Gemm g{S5, WDOWN, M, 1024, 3072}; pg8::StaticOrder S; S.init(M, 1024, G, bx);
              pg8::EpiFinal E{PP(out), PP(out), md + 5120, PP(g_final), rssB, (unsigned*)(ws + WS_FCNT)};
              pg8::gemm_phase<pg8::EpiFinal, pg8::StaticOrder, true, true>(lds, g, S, E, CUR_TID()); }
        }
        SEAM(pb + 5);
    }
#undef IN
#undef SEAM
}

#ifndef MK_ONE_LAUNCH
#define MK_ONE_LAUNCH 1
#endif
extern "C" void kernel_launch(void* const* d_in, const int* in_sizes, int n_in, void* d_out, int out_size, void* d_ws, size_t ws_size, hipStream_t stream) {
    static int grid = 0;
    if (grid == 0) {
        int dev = 0, cus = 0;
        (void)hipGetDevice(&dev); (void)hipDeviceGetAttribute(&cus, hipDeviceAttributeMultiprocessorCount, dev);
        if (hipFuncSetAttribute((const void*)mk_fwd, hipFuncAttributeMaxDynamicSharedMemorySize, LDS_BYTES) != hipSuccess) { fprintf(stderr, "kernel_launch: hipFuncSetAttribute failed\n"); grid = -1; return; }
        grid = 256;
        if (cus != 256) fprintf(stderr, "kernel_launch: %d CUs reported; this kernel is built for 256\n", cus);
        if (ws_size < 8 * SLOT) { fprintf(stderr, "kernel_launch: workspace too small (%zu)\n", ws_size); grid = -1; return; }
    }
    if (grid < 0) return;
    (void)hipMemsetAsync(d_ws, 0, WS_CTLZERO, stream);
    Params p{};
    p.x = (const float*)d_in[0]; p.c = (const float*)d_in[1]; p.pos = (const int*)d_in[2];
    p.w_mod = (const float*)d_in[3]; p.b_mod = (const float*)d_in[4]; p.g_mix = (const float*)d_in[5]; p.w_in = (const float*)d_in[6];
    p.lq1 = (const float*)d_in[7]; p.lk1 = (const float*)d_in[8]; p.lq2 = (const float*)d_in[9]; p.lk2 = (const float*)d_in[10]; p.g_subln = (const float*)d_in[11];
    p.conv_rnn_w = (const float*)d_in[12]; p.conv_rnn_b = (const float*)d_in[13]; p.w_rg_a = (const float*)d_in[14]; p.b_rg_a = (const float*)d_in[15];
    p.w_rg_i = (const float*)d_in[16]; p.b_rg_i = (const float*)d_in[17]; p.lam_rg = (const float*)d_in[18]; p.w_out = (const float*)d_in[19]; p.g_ffn = (const float*)d_in[20];
    p.w_up = (const float*)d_in[21]; p.conv_ffn_w = (const float*)d_in[22]; p.conv_ffn_b = (const float*)d_in[23]; p.w_down = (const float*)d_in[24]; p.g_final = (const float*)d_in[25];
    p.out = (float*)d_out; p.ws = (unsigned char*)d_ws;
#if MK_ONE_LAUNCH
    p.ph_lo = 0; p.ph_hi = N_PHASES;
    hipLaunchKernelGGL(mk_fwd, dim3(grid), dim3(NTHREADS), LDS_BYTES, stream, p);
#else
    for (int ph = 0; ph < N_PHASES; ++ph) { p.ph_lo = ph; p.ph_hi = ph + 1; hipLaunchKernelGGL(mk_fwd, dim3(grid), dim3(NTHREADS), LDS_BYTES, stream, p); }
#endif
}
```

```cpp
#include <hip/hip_runtime.h>
#include <stdint.h>
#include <cstdio>
#include <cstdint>
#include <cstddef>

constexpr int NB = 2, SEQ = 8192, DM = 1024, M = NB * SEQ, NIN = 7168, DFF = 3072, NUP = 6144;
constexpr size_t MiB = 1u << 20;
constexpr size_t SLOT = 32 * MiB;

namespace pg8 {
#define PG8_LAS __attribute__((address_space(3)))
typedef unsigned short bf16_t;
typedef short bf16x8 __attribute__((ext_vector_type(8)));
typedef float f32x4 __attribute__((ext_vector_type(4)));
typedef unsigned u32x4 __attribute__((ext_vector_type(4)));
constexpr int BM = 256, BK = 64, HALF = 128, HTB = HALF * BK * 2  , STAGE_BYTES = 8 * HTB, NXCD = 8, WGM = 8;

__host__ __device__ __forceinline__ int lds_byte(int r, int c) { const int st = (r >> 4) * 2 + (c >> 5), rr = r & 15, cc = c & 31, ob = rr * 64 + cc * 2; return st * 1024 + (ob ^ (((ob >> 9) & 1) << 5)); }
__host__ __device__ __forceinline__ void stage_rc(int b, int& R, int& C) { const int st = b / 1024, sb = b % 1024, swz = sb ^ (((sb >> 9) & 1) << 5); R = (st >> 1) * 16 + swz / 64; C = (st & 1) * 32 + (swz % 64) / 2; }
__host__ __device__ __forceinline__ int perm32(int rho) { const int n = rho >> 4, i = rho & 15; return 8 * (i >> 2) + 4 * n + (i & 3); }

struct Unit { int pm, pn; };
struct Gemm { const bf16_t* A; const bf16_t* Bt; int M, N, K; };

struct StaticOrder {
    int nM, nN, nwg, G, c;
    __host__ __device__ void init(int M, int N, int G_, int c_) { nM = M / BM; nN = N / BM; nwg = nM * nN; G = G_; c = c_; }
    __host__ __device__ bool next(int i, Unit& u) const {
        const long L = (long)i * G + c; if (L >= nwg) return false;
        int wgid = (int)L; { const int q = nwg / NXCD, r = nwg % NXCD, xcd = wgid % NXCD, off = wgid / NXCD; wgid = (xcd < r ? xcd * (q + 1) : r * (q + 1) + (xcd - r) * q) + off; }
        const int nig = WGM * nN, gid = wgid / nig, fm = gid * WGM, gsz = (nM - fm) < WGM ? (nM - fm) : WGM;
        u.pm = fm + ((wgid % nig) % gsz); u.pn = (wgid % nig) / gsz; return true;
    }
    __device__ __forceinline__ void a_ready(const Unit&) const {}
    __device__ __forceinline__ void done(const Unit&) const {}
};

__device__ __forceinline__ unsigned cvt_pk_bf16(float lo, float hi) { unsigned r; asm volatile("v_cvt_pk_bf16_f32 %0, %1, %2" : "=v"(r) : "v"(lo), "v"(hi)); return r; }

typedef unsigned u32x2 __attribute__((ext_vector_type(2)));
__device__ __forceinline__ float fast_sigmoid(float x) { return __builtin_amdgcn_rcpf(1.0f + __expf(-x)); }
__device__ __forceinline__ float fast_gelu(float x) { const float u = 1.5957691216057308f * (x + 0.044715f * x * x * x); return x * __builtin_amdgcn_rcpf(1.0f + __expf(-u)); }
__device__ __forceinline__ float gelu_mul(float g, float v) { const float t = g * g, p = __builtin_fmaf(t, -2.3022081985f * 0.044715f, -2.3022081985f); return (g * v) * __builtin_amdgcn_rcpf(1.0f + __builtin_amdgcn_exp2f(p * g)); }
constexpr float EPS_ = 1e-6f;
constexpr float C2Q = 0.125f * 1.4426950408889634f;

struct EpiIn {
    static constexpr bool PERM = true, APERM = false, AFTER_DRAIN = false;
    bf16_t* slots; const float *cs, *sn, *rowss, *bias;
    __device__ __forceinline__ void operator()(const f32x4 (&acc)[2][2][4][2], const Unit& u, int wr, int wc, int fr_, int fq_) const {
        int fr = fr_, fq = fq_; asm volatile("" : "+v"(fr), "+v"(fq));
        const int b = u.pm >> 5, pn = u.pn, pbase = wc * 32 + 8 * fq;
        bf16_t* const dstb = slots + (size_t)(pn < 16 ? (pn >> 2) : (pn < 24 ? 5 : 4)) * ((size_t)16384 * 1024);
        f32x4 bv[2][2];
#pragma unroll
        for (int bj = 0; bj < 2; ++bj)
#pragma unroll
            for (int n = 0; n < 2; ++n) bv[bj][n] = *(const f32x4*)(bias + b * 7168 + pn * 256 + bj * 128 + pbase + 4 * n);
        float rsv[2][4];
#pragma unroll
        for (int ai = 0; ai < 2; ++ai)
#pragma unroll
            for (int m = 0; m < 4; ++m) rsv[ai][m] = rowss[u.pm * BM + ai * HALF + wr * 64 + m * 16 + fr];
#pragma unroll
        for (int ai = 0; ai < 2; ++ai)
#pragma unroll
            for (int m = 0; m < 4; ++m) {
                const int row = u.pm * BM + ai * HALF + wr * 64 + m * 16 + fr;
                const float rstd = __builtin_amdgcn_rsqf(rsv[ai][m] * (1.0f / 1024.0f) + EPS_);
                if (pn < 8) {
                    const float scl = pn < 4 ? C2Q : 1.0f;
                    bf16_t* base = dstb + (size_t)row * 1024 + (4 * (pn & 3) + wc) * 64 + 8 * fq;
                    f32x4 o1[2], o2[2];
#pragma unroll
                    for (int n = 0; n < 2; ++n) {
                        const f32x4 c4 = *(const f32x4*)(cs + (size_t)row * 32 + 8 * fq + 4 * n), s4 = *(const f32x4*)(sn + (size_t)row * 32 + 8 * fq + 4 * n);
                        const f32x4 t1 = acc[ai][0][m][n] * rstd + bv[0][n], t2 = acc[ai][1][m][n] * rstd + bv[1][n];
                        o1[n] = (t1 * c4 - t2 * s4) * scl; o2[n] = (t2 * c4 + t1 * s4) * scl;
                    }
                    u32x4 w1, w2;
                    w1.x = cvt_pk_bf16(o1[0][0], o1[0][1]); w1.y = cvt_pk_bf16(o1[0][2], o1[0][3]); w1.z = cvt_pk_bf16(o1[1][0], o1[1][1]); w1.w = cvt_pk_bf16(o1[1][2], o1[1][3]);
                    w2.x = cvt_pk_bf16(o2[0][0], o2[0][1]); w2.y = cvt_pk_bf16(o2[0][2], o2[0][3]); w2.z = cvt_pk_bf16(o2[1][0], o2[1][1]); w2.w = cvt_pk_bf16(o2[1][2], o2[1][3]);
                    *(u32x4*)base = w1; *(u32x4*)(base + 32) = w2;
                } else if (pn < 16 || pn >= 24) {
                    bf16_t* base = dstb + (size_t)row * 1024 + (pn & 3) * 256 + pbase;
#pragma unroll
                    for (int bj = 0; bj < 2; ++bj) {
                        f32x4 v0 = acc[ai][bj][m][0] * rstd + bv[bj][0], v1 = acc[ai][bj][m][1] * rstd + bv[bj][1];
                        if (pn >= 24) {
#pragma unroll
                            for (int e = 0; e < 4; ++e) { v0[e] = fast_sigmoid(v0[e]); v1[e] = fast_sigmoid(v1[e]); }
                        }
                        u32x4 w; w.x = cvt_pk_bf16(v0[0], v0[1]); w.y = cvt_pk_bf16(v0[2], v0[3]); w.z = cvt_pk_bf16(v1[0], v1[1]); w.w = cvt_pk_bf16(v1[2], v1[3]);
                        *(u32x4*)(base + bj * HALF) = w;
                    }
                } else {
                    bf16_t* base = dstb + (size_t)row * 1024 + (pn - 16) * 128 + pbase;
                    f32x4 o[2];
#pragma unroll
                    for (int n = 0; n < 2; ++n) {
                        const f32x4 yr = acc[ai][0][m][n] * rstd + bv[0][n], gr = acc[ai][1][m][n] * rstd + bv[1][n];
#pragma unroll
                        for (int e = 0; e < 4; ++e) o[n][e] = fast_sigmoid(gr[e]) * fast_gelu(yr[e]);
                    }
                    u32x4 w; w.x = cvt_pk_bf16(o[0][0], o[0][1]); w.y = cvt_pk_bf16(o[0][2], o[0][3]); w.z = cvt_pk_bf16(o[1][0], o[1][1]); w.w = cvt_pk_bf16(o[1][2], o[1][3]);
                    *(u32x4*)base = w;
                }
                if (m & 1) asm volatile("" ::: "memory");
            }
    }
};

struct EpiRes {
    static constexpr bool PERM = true, APERM = false, AFTER_DRAIN = false;
    const float* xin32; const bf16_t* xin16; bf16_t* xout; const float* gt; const float* gnext; const float* scnext; bf16_t* xa; float* rowss;
    __device__ __forceinline__ void operator()(const f32x4 (&acc)[2][2][4][2], const Unit& u, int wr, int wc, int fr_, int fq_) const {
        int fr = fr_, fq = fq_; asm volatile("" : "+v"(fr), "+v"(fq));
        const int b = u.pm >> 5, col0 = u.pn * BM + wc * 32 + 8 * fq;
        f32x4 g4[2][2], gm[2][2];
#pragma unroll
        for (int bj = 0; bj < 2; ++bj)
#pragma unroll
            for (int n = 0; n < 2; ++n) { const int c = col0 + bj * HALF + 4 * n; g4[bj][n] = *(const f32x4*)(gt + b * 6144 + c);
                gm[bj][n] = xa ? *(const f32x4*)(gnext + c) * (*(const f32x4*)(scnext + b * 6144 + c) + 1.0f) : (f32x4){0.f, 0.f, 0.f, 0.f}; }
#pragma unroll
        for (int ai = 0; ai < 2; ++ai)
#pragma unroll
            for (int m = 0; m < 4; ++m) {
                const int row = u.pm * BM + ai * HALF + wr * 64 + m * 16 + fr; const size_t off = (size_t)row * 1024 + col0;
                float ssq = 0.f;
#pragma unroll
                for (int bj = 0; bj < 2; ++bj) {
                    f32x4 r0, r1;
                    if (xin32) { r0 = *(const f32x4*)(xin32 + off + bj * HALF); r1 = *(const f32x4*)(xin32 + off + bj * HALF + 4); }
                    else { const u32x4 rw = *(const u32x4*)(xin16 + off + bj * HALF);
                        r0 = (f32x4){__uint_as_float(rw.x << 16), __uint_as_float(rw.x & 0xffff0000u), __uint_as_float(rw.y << 16), __uint_as_float(rw.y & 0xffff0000u)};
                        r1 = (f32x4){__uint_as_float(rw.z << 16), __uint_as_float(rw.z & 0xffff0000u), __uint_as_float(rw.w << 16), __uint_as_float(rw.w & 0xffff0000u)}; }
                    const f32x4 x0 = r0 + g4[bj][0] * acc[ai][bj][m][0], x1 = r1 + g4[bj][1] * acc[ai][bj][m][1];
                    { u32x4 xw; xw.x = cvt_pk_bf16(x0[0], x0[1]); xw.y = cvt_pk_bf16(x0[2], x0[3]); xw.z = cvt_pk_bf16(x1[0], x1[1]); xw.w = cvt_pk_bf16(x1[2], x1[3]); *(u32x4*)(xout + off + bj * HALF) = xw; }
                    ssq += (x0[0] * x0[0] + x0[1] * x0[1]) + (x0[2] * x0[2] + x0[3] * x0[3]) + (x1[0] * x1[0] + x1[1] * x1[1]) + (x1[2] * x1[2] + x1[3] * x1[3]);
                    if (xa) { const f32x4 a0 = x0 * gm[bj][0], a1 = x1 * gm[bj][1];
                        u32x4 w; w.x = cvt_pk_bf16(a0[0], a0[1]); w.y = cvt_pk_bf16(a0[2], a0[3]); w.z = cvt_pk_bf16(a1[0], a1[1]); w.w = cvt_pk_bf16(a1[2], a1[3]);
                        *(u32x4*)(xa + off + bj * HALF) = w; }
                }
                ssq += __shfl_xor(ssq, 16); ssq += __shfl_xor(ssq, 32);
                if (fq == 0) atomicAdd(rowss + row, ssq);
                if (m & 1) asm volatile("" ::: "memory");
            }
    }
};

struct EpiFinal {
    static constexpr bool PERM = true, APERM = false, AFTER_DRAIN = false;
    const bf16_t* xin; float* out; const float* gt; const float* gfin; float* rowss; unsigned* cnt;
    __device__ __forceinline__ void operator()(f32x4 (&acc)[2][2][4][2], const Unit& u, int wr, int wc, int fr_, int fq_) const {
        int fr = fr_, fq = fq_; asm volatile("" : "+v"(fr), "+v"(fq));
        const int b = u.pm >> 5, col0 = u.pn * BM + wc * 32 + 8 * fq;
        {
            f32x4 g4[2][2];
#pragma unroll
            for (int bj = 0; bj < 2; ++bj)
#pragma unroll
                for (int n = 0; n < 2; ++n) g4[bj][n] = *(const f32x4*)(gt + b * 6144 + col0 + bj * HALF + 4 * n);
#pragma unroll
            for (int ai = 0; ai < 2; ++ai)
#pragma unroll
                for (int m = 0; m < 4; ++m) {
                    const int row = u.pm * BM + ai * HALF + wr * 64 + m * 16 + fr; const size_t off = (size_t)row * 1024 + col0;
                    float ssq = 0.f;
#pragma unroll
                    for (int bj = 0; bj < 2; ++bj) {
                        const u32x4 rw = *(const u32x4*)(xin + off + bj * HALF);
                        const f32x4 r0 = {__uint_as_float(rw.x << 16), __uint_as_float(rw.x & 0xffff0000u), __uint_as_float(rw.y << 16), __uint_as_float(rw.y & 0xffff0000u)};
                        const f32x4 r1 = {__uint_as_float(rw.z << 16), __uint_as_float(rw.z & 0xffff0000u), __uint_as_float(rw.w << 16), __uint_as_float(rw.w & 0xffff0000u)};
                        const f32x4 x0 = r0 + g4[bj][0] * acc[ai][bj][m][0], x1 = r1 + g4[bj][1] * acc[ai][bj][m][1];
                        acc[ai][bj][m][0] = x0; acc[ai][bj][m][1] = x1;
                        ssq += (x0[0] * x0[0] + x0[1] * x0[1]) + (x0[2] * x0[2] + x0[3] * x0[3]) + (x1[0] * x1[0] + x1[1] * x1[1]) + (x1[2] * x1[2] + x1[3] * x1[3]);
                    }
                    ssq += __shfl_xor(ssq, 16); ssq += __shfl_xor(ssq, 32);
                    if (fq == 0) atomicAdd(rowss + row, ssq);
                    if (m & 1) asm volatile("" ::: "memory");
                }
        }
        asm volatile("s_waitcnt vmcnt(0)" ::: "memory"); __builtin_amdgcn_s_barrier(); asm volatile("" ::: "memory");
        if (wr == 0 && wc == 0 && fr == 0 && fq == 0) __hip_atomic_fetch_add(cnt + u.pm, 1u, __ATOMIC_RELAXED, __HIP_MEMORY_SCOPE_AGENT);
        { unsigned spins = 0; while (__hip_atomic_load(cnt + u.pm, __ATOMIC_RELAXED, __HIP_MEMORY_SCOPE_AGENT) < 4u && ++spins < (1u << 22)) __builtin_amdgcn_s_sleep(2); }
        asm volatile("" ::: "memory");
        f32x4 gf[2][2];
#pragma unroll
        for (int bj = 0; bj < 2; ++bj)
#pragma unroll
            for (int n = 0; n < 2; ++n) gf[bj][n] = *(const f32x4*)(gfin + col0 + bj * HALF + 4 * n);
#pragma unroll
        for (int ai = 0; ai < 2; ++ai)
#pragma unroll
            for (int m = 0; m < 4; ++m) {
                const int row = u.pm * BM + ai * HALF + wr * 64 + m * 16 + fr; const size_t off = (size_t)row * 1024 + col0;
                const float rstd = __builtin_amdgcn_rsqf(__hip_atomic_load(rowss + row, __ATOMIC_RELAXED, __HIP_MEMORY_SCOPE_AGENT) * (1.0f / 1024.0f) + EPS_);
#pragma unroll
                for (int bj = 0; bj < 2; ++bj) { *(f32x4*)(out + off + bj * HALF) = acc[ai][bj][m][0] * rstd * gf[bj][0]; *(f32x4*)(out + off + bj * HALF + 4) = acc[ai][bj][m][1] * rstd * gf[bj][1]; }
            }
    }
};

template <int CTRL> __device__ __forceinline__ float dpp_ror(float x) { return __int_as_float(__builtin_amdgcn_update_dpp(0, __float_as_int(x), CTRL, 0xf, 0xf, true)); }
struct EpiUpConv {
    static constexpr bool PERM = true, APERM = true, AFTER_DRAIN = false;
    bf16_t* act; const float* rowss; const float* bias; const float* cw; const float* cb; float* halo; unsigned* flags; PG8_LAS float* tails;
    static __device__ __forceinline__ float shr1_old(float old, float x) { return __int_as_float(__builtin_amdgcn_update_dpp(__float_as_int(old), __float_as_int(x), 0x111, 0xf, 0xf, false)); }
    __device__ __forceinline__ void operator()(f32x4 (&acc)[2][2][4][2], const Unit& u, int wr, int wc, int fr_, int fq_) const {
        int fr = fr_, fq = fq_; asm volatile("" : "+v"(fr), "+v"(fq));
        const int b = u.pm >> 5, pn = u.pn, colp = wc * 32 + 8 * fq;
        {
            f32x4 bv[2][2];
#pragma unroll
            for (int bj = 0; bj < 2; ++bj)
#pragma unroll
                for (int n = 0; n < 2; ++n) bv[bj][n] = *(const f32x4*)(bias + b * 6144 + pn * 256 + bj * 128 + colp + 4 * n);
#pragma unroll
            for (int ai = 0; ai < 2; ++ai) {
                const f32x4 ss = *(const f32x4*)(rowss + u.pm * BM + ai * HALF + wr * 64 + 4 * fr);
#pragma unroll
                for (int m = 0; m < 4; ++m) {
                    const float rstd = __builtin_amdgcn_rsqf(ss[m] * (1.0f / 1024.0f) + EPS_);
#pragma unroll
                    for (int bj = 0; bj < 2; ++bj)
#pragma unroll
                        for (int n = 0; n < 2; ++n) acc[ai][bj][m][n] = acc[ai][bj][m][n] * rstd + bv[bj][n];
                }
            }
        }
        if (fr == 15) {
#pragma unroll
            for (int ai = 0; ai < 2; ++ai)
#pragma unroll
                for (int bj = 0; bj < 2; ++bj)
#pragma unroll
                    for (int n = 0; n < 2; ++n) {
                        *(PG8_LAS f32x4*)(tails + ((2 * ai + wr) * 2 + 0) * 256 + bj * 128 + colp + 4 * n) = acc[ai][bj][2][n];
                        *(PG8_LAS f32x4*)(tails + ((2 * ai + wr) * 2 + 1) * 256 + bj * 128 + colp + 4 * n) = acc[ai][bj][3][n]; }
            if (wr == 1) {
#pragma unroll
                for (int j = 0; j < 2; ++j) {
                    unsigned long long* hp = (unsigned long long*)(halo + ((size_t)(u.pm * 24 + pn) * 2 + j) * 256 + colp);
#pragma unroll
                    for (int bj = 0; bj < 2; ++bj)
#pragma unroll
                        for (int n = 0; n < 2; ++n) { const f32x4 v = acc[1][bj][2 + j][n];
                            __hip_atomic_store(hp + (bj * 128 + 4 * n) / 2, ((unsigned long long)__float_as_uint(v[1]) << 32) | __float_as_uint(v[0]), __ATOMIC_RELAXED, __HIP_MEMORY_SCOPE_AGENT);
                            __hip_atomic_store(hp + (bj * 128 + 4 * n) / 2 + 1, ((unsigned long long)__float_as_uint(v[3]) << 32) | __float_as_uint(v[2]), __ATOMIC_RELAXED, __HIP_MEMORY_SCOPE_AGENT); }
                }
            }
        }
        asm volatile("s_waitcnt vmcnt(0) lgkmcnt(0)" ::: "memory"); __builtin_amdgcn_s_barrier(); asm volatile("" ::: "memory");
        if (wr == 1 && wc == 0 && fr == 0 && fq == 0) __hip_atomic_store(flags + u.pm * 24 + pn, 1u, __ATOMIC_RELAXED, __HIP_MEMORY_SCOPE_AGENT);
        u32x2 held[2][4];
#pragma unroll
        for (int n = 0; n < 2; ++n) {
            f32x4 w0[2], w1[2], w2[2], cbv[2];
#pragma unroll
            for (int bj = 0; bj < 2; ++bj) { const int ch = bj * 3072 + pn * 128 + colp + 4 * n;
                w0[bj] = *(const f32x4*)(cw + ch); w1[bj] = *(const f32x4*)(cw + 6144 + ch); w2[bj] = *(const f32x4*)(cw + 2 * 6144 + ch); cbv[bj] = *(const f32x4*)(cb + ch); }
#pragma unroll
            for (int aix = 0; aix < 2; ++aix) {
                const int ai = 1 - aix, g = 2 * ai + wr;
                f32x4 t14[2], t15[2];
                if (g > 0) {
#pragma unroll
                    for (int bj = 0; bj < 2; ++bj) { t14[bj] = *(const PG8_LAS f32x4*)(tails + ((g - 1) * 2 + 0) * 256 + bj * 128 + colp + 4 * n); t15[bj] = *(const PG8_LAS f32x4*)(tails + ((g - 1) * 2 + 1) * 256 + bj * 128 + colp + 4 * n); }
                } else if ((u.pm & 31) == 0) {
                    t14[0] = t14[1] = t15[0] = t15[1] = (f32x4){0.f, 0.f, 0.f, 0.f};
                } else {
                    unsigned* fl = flags + (u.pm - 1) * 24 + pn; unsigned spins = 0;
                    while (__hip_atomic_load(fl, __ATOMIC_RELAXED, __HIP_MEMORY_SCOPE_AGENT) == 0u && ++spins < (1u << 22)) __builtin_amdgcn_s_sleep(2);
                    asm volatile("" ::: "memory");
                    const unsigned long long* hp = (const unsigned long long*)(halo + ((size_t)((u.pm - 1) * 24 + pn) * 2) * 256 + colp);
#pragma unroll
                    for (int bj = 0; bj < 2; ++bj) {
                        const unsigned long long a0 = __hip_atomic_load(hp + (bj * 128 + 4 * n) / 2, __ATOMIC_RELAXED, __HIP_MEMORY_SCOPE_AGENT), a1 = __hip_atomic_load(hp + (bj * 128 + 4 * n) / 2 + 1, __ATOMIC_RELAXED, __HIP_MEMORY_SCOPE_AGENT);
                        const unsigned long long c0 = __hip_atomic_load(hp + 128 + (bj * 128 + 4 * n) / 2, __ATOMIC_RELAXED, __HIP_MEMORY_SCOPE_AGENT), c1 = __hip_atomic_load(hp + 128 + (bj * 128 + 4 * n) / 2 + 1, __ATOMIC_RELAXED, __HIP_MEMORY_SCOPE_AGENT);
                        t14[bj] = (f32x4){__uint_as_float((unsigned)a0), __uint_as_float((unsigned)(a0 >> 32)), __uint_as_float((unsigned)a1), __uint_as_float((unsigned)(a1 >> 32))};
                        t15[bj] = (f32x4){__uint_as_float((unsigned)c0), __uint_as_float((unsigned)(c0 >> 32)), __uint_as_float((unsigned)c1), __uint_as_float((unsigned)(c1 >> 32))}; }
                }
                f32x4 y[2][4];
#pragma unroll
                for (int bj = 0; bj < 2; ++bj) {
                    const f32x4 x0 = acc[ai][bj][0][n], x1 = acc[ai][bj][1][n], x2 = acc[ai][bj][2][n], x3 = acc[ai][bj][3][n];
                    f32x4 s3, s2;
#pragma unroll
                    for (int e = 0; e < 4; ++e) { s3[e] = shr1_old(t15[bj][e], x3[e]); s2[e] = shr1_old(t14[bj][e], x2[e]); }
                    y[bj][0] = cbv[bj] + w2[bj] * x0 + w1[bj] * s3 + w0[bj] * s2;
                    y[bj][1] = cbv[bj] + w2[bj] * x1 + w1[bj] * x0 + w0[bj] * s3;
                    y[bj][2] = cbv[bj] + w2[bj] * x2 + w1[bj] * x1 + w0[bj] * x0;
                    y[bj][3] = cbv[bj] + w2[bj] * x3 + w1[bj] * x2 + w0[bj] * x1;
                }
#pragma unroll
                for (int m = 0; m < 4; ++m) {
                    f32x4 o;
#pragma unroll
                    for (int e = 0; e < 4; ++e) o[e] = gelu_mul(y[1][m][e], y[0][m][e]);
                    u32x2 w; w.x = cvt_pk_bf16(o[0], o[1]); w.y = cvt_pk_bf16(o[2], o[3]);
                    if (n == 0) held[ai][m] = w;
                    else { u32x4 ww; ww.x = held[ai][m].x; ww.y = held[ai][m].y; ww.z = w.x; ww.w = w.y;
                        *(u32x4*)(act + (size_t)(u.pm * BM + ai * HALF + wr * 64 + 4 * fr + m) * 3072 + pn * 128 + colp) = ww; }
                }
                asm volatile("" ::: "memory");
            }
        }
        asm volatile("s_waitcnt lgkmcnt(0)" ::: "memory"); __builtin_amdgcn_s_barrier(); asm volatile("" ::: "memory");
    }
};
template <class Epi, class Sched, bool ALIGN_EPI = false, bool SP2 = false>
__device__ __forceinline__ void gemm_phase(PG8_LAS unsigned char* lds, const Gemm g, const Sched& S, const Epi& E, int tid_in) {
    int tid_l = tid_in; asm volatile("" : "+v"(tid_l));
    const int tid = tid_l, wid = __builtin_amdgcn_readfirstlane(tid >> 6), lane = tid & 63, wr = wid >> 2, wc = wid & 3, fr = lane & 15, fq = lane >> 4;
    const int K = g.K, nt = K / BK;
    unsigned voffA[2], voffB[2];
#pragma unroll
    for (int i = 0; i < 2; ++i) { int R, C; stage_rc(tid * 16 + i * 8192, R, C); const int Rb = Epi::PERM ? ((R & ~31) + perm32(R & 31)) : R;
        const int Ra = Epi::APERM ? ((R & ~63) + 4 * (R & 15) + ((R >> 4) & 3)) : R;
        voffA[i] = (unsigned)(Ra * K + C) * 2u; voffB[i] = (unsigned)(Rb * K + C) * 2u; }
    const size_t kstep = (size_t)(BK * 2);
    const size_t hstep = (size_t)HALF * K * 2;
    const size_t tstep = 2 * hstep;
    const unsigned ldsw = (unsigned)wid * 1024u;
    const int aoff = lds_byte(wr * 64 + fr, fq * 8), boff = lds_byte(wc * 32 + fr, fq * 8);
#define PG8_SA(b, h) (((b) * 2 + (h)) * HTB)
#define PG8_SB(b, h) ((4 + (b) * 2 + (h)) * HTB)
#define PG8_STAGE(bufoff, gbase, voff) do { _Pragma("unroll") for (int _i = 0; _i < 2; ++_i) \
        __builtin_amdgcn_global_load_lds((const unsigned*)((const char*)(gbase) + (voff)[_i]), (PG8_LAS unsigned*)(lds + (bufoff) + ldsw + _i * 8192), 16, 0, 0); } while (0)
#define PG8_LDA(dst, b, h) do { _Pragma("unroll") for (int m = 0; m < 4; ++m) _Pragma("unroll") for (int k = 0; k < 2; ++k) dst[m][k] = *(const PG8_LAS bf16x8*)(lds + PG8_SA(b, h) + aoff + m * 2048 + k * 1024); } while (0)
#define PG8_LDB(dst, b, h) do { _Pragma("unroll") for (int n = 0; n < 2; ++n) _Pragma("unroll") for (int k = 0; k < 2; ++k) dst[n][k] = *(const PG8_LAS bf16x8*)(lds + PG8_SB(b, h) + boff + n * 2048 + k * 1024); } while (0)
#define PG8_MMA(ai, bj, At, Bt) do { __builtin_amdgcn_s_setprio(1); _Pragma("unroll") for (int m = 0; m < 4; ++m) _Pragma("unroll") for (int n = 0; n < 2; ++n) _Pragma("unroll") for (int k = 0; k < 2; ++k) \
        acc[ai][bj][m][n] = __builtin_amdgcn_mfma_f32_16x16x32_bf16(Bt[n][k], At[m][k], acc[ai][bj][m][n], 0, 0, 0); __builtin_amdgcn_s_setprio(0); } while (0)
#define PG8_WAIT_V(n) asm volatile("s_waitcnt vmcnt(" #n ")" ::: "memory")
#define PG8_WAIT_L(n) asm volatile("s_waitcnt lgkmcnt(" #n ")" ::: "memory")
#define PG8_BAR __builtin_amdgcn_s_barrier()
#define PG8_SCHED __builtin_amdgcn_sched_barrier(0)
    Unit cur, nxt; int ui = 0;
    if (!S.next(0, cur)) return;
    f32x4 acc[2][2][4][2];
#pragma unroll
    for (int a = 0; a < 2; ++a)
#pragma unroll
        for (int b = 0; b < 2; ++b)
#pragma unroll
            for (int m = 0; m < 4; ++m)
#pragma unroll
                for (int n = 0; n < 2; ++n) acc[a][b][m][n] = (f32x4){0.f, 0.f, 0.f, 0.f};
    bf16x8 At[4][2], B0[2][2], B1[2][2];
    const char* cA = (const char*)g.A + (size_t)cur.pm * tstep; const char* cB = (const char*)g.Bt + (size_t)cur.pn * tstep;
    S.a_ready(cur);
    if constexpr (SP2) {
        PG8_STAGE(PG8_SB(0, 0), cB, voffB); PG8_STAGE(PG8_SB(0, 1), cB + hstep, voffB); PG8_STAGE(PG8_SA(0, 0), cA, voffA); PG8_STAGE(PG8_SA(0, 1), cA + hstep, voffA);
        if (wr == 1) PG8_BAR;
        PG8_WAIT_V(2); PG8_BAR;
        PG8_STAGE(PG8_SB(1, 0), cB + kstep, voffB); PG8_STAGE(PG8_SA(1, 0), cA + kstep, voffA); PG8_STAGE(PG8_SB(1, 1), cB + hstep + kstep, voffB);
        PG8_WAIT_V(6); PG8_BAR;
    } else {
        PG8_STAGE(PG8_SB(0, 0), cB, voffB); PG8_STAGE(PG8_SA(0, 0), cA, voffA); PG8_STAGE(PG8_SB(0, 1), cB + hstep, voffB); PG8_STAGE(PG8_SA(0, 1), cA + hstep, voffA);
        if (wr == 1) PG8_BAR;
        PG8_WAIT_V(4); PG8_BAR;
        PG8_STAGE(PG8_SB(1, 0), cB + kstep, voffB); PG8_STAGE(PG8_SA(1, 0), cA + kstep, voffA); PG8_STAGE(PG8_SB(1, 1), cB + hstep + kstep, voffB);
        PG8_WAIT_V(6); PG8_BAR;
    }
    for (;;) {
        const bool has_next = S.next(ui + 1, nxt);
        const char* nA = has_next ? (const char*)g.A + (size_t)nxt.pm * tstep : cA; const char* nB = has_next ? (const char*)g.Bt + (size_t)nxt.pn * tstep : cB;
        for (int t = 0; t < nt; t += 2) {
            asm volatile("" : "+v"(voffA[0]), "+v"(voffA[1]), "+v"(voffB[0]), "+v"(voffB[1]));
            const bool last = (t == nt - 2);
            const char* a1 = cA + (size_t)(t + 1) * kstep;
            const char* a2 = last ? nA : cA + (size_t)(t + 2) * kstep; const char* b2 = last ? nB : cB + (size_t)(t + 2) * kstep;
            const char* a3 = a2 + kstep; const char* b3 = b2 + kstep;
            if (last && has_next) S.a_ready(nxt);
            if constexpr (SP2) {
            PG8_LDB(B0, 0, 0); PG8_LDB(B1, 0, 1); PG8_SCHED; PG8_LDA(At, 0, 0); PG8_STAGE(PG8_SA(1, 1), a1 + hstep, voffA);
            PG8_WAIT_V(8); PG8_WAIT_L(0); PG8_BAR; PG8_MMA(0, 0, At, B0); PG8_MMA(0, 1, At, B1); PG8_BAR; PG8_SCHED;
            PG8_LDA(At, 0, 1); PG8_STAGE(PG8_SB(0, 0), b2, voffB); PG8_STAGE(PG8_SB(0, 1), b2 + hstep, voffB); PG8_STAGE(PG8_SA(0, 0), a2, voffA);
            PG8_WAIT_V(8); PG8_WAIT_L(0); PG8_BAR; PG8_MMA(1, 0, At, B0); PG8_MMA(1, 1, At, B1); PG8_BAR; PG8_SCHED;
            PG8_LDB(B0, 1, 0); PG8_LDB(B1, 1, 1); PG8_SCHED; PG8_LDA(At, 1, 0); PG8_STAGE(PG8_SA(0, 1), a2 + hstep, voffA);
            PG8_WAIT_V(8); PG8_WAIT_L(0); PG8_BAR; PG8_MMA(0, 0, At, B0); PG8_MMA(0, 1, At, B1); PG8_BAR; PG8_SCHED;
            PG8_LDA(At, 1, 1); PG8_STAGE(PG8_SB(1, 0), b3, voffB); PG8_STAGE(PG8_SB(1, 1), b3 + hstep, voffB); PG8_STAGE(PG8_SA(1, 0), a3, voffA);
            PG8_WAIT_V(8); PG8_WAIT_L(0); PG8_BAR; PG8_MMA(1, 0, At, B0); PG8_MMA(1, 1, At, B1); PG8_BAR; PG8_SCHED;
            } else {
            PG8_LDB(B0, 0, 0); PG8_SCHED; PG8_LDA(At, 0, 0); PG8_STAGE(PG8_SA(1, 1), a1 + hstep, voffA);
            PG8_WAIT_L(8); PG8_BAR; PG8_WAIT_L(0); PG8_MMA(0, 0, At, B0); PG8_BAR; PG8_SCHED;
            PG8_LDB(B1, 0, 1); PG8_STAGE(PG8_SB(0, 0), b2, voffB);
            PG8_BAR; PG8_WAIT_L(0); PG8_MMA(0, 1, At, B1); PG8_BAR;
            PG8_LDA(At, 0, 1); PG8_STAGE(PG8_SA(0, 0), a2, voffA);
            PG8_BAR; PG8_WAIT_L(0); PG8_MMA(1, 0, At, B0); PG8_BAR; PG8_SCHED;
            PG8_STAGE(PG8_SB(0, 1), b2 + hstep, voffB);
            PG8_WAIT_V(6); PG8_BAR; PG8_MMA(1, 1, At, B1); PG8_BAR;
            PG8_LDB(B0, 1, 0); PG8_SCHED; PG8_LDA(At, 1, 0); PG8_STAGE(PG8_SA(0, 1), a2 + hstep, voffA);
            PG8_WAIT_L(8); PG8_BAR; PG8_WAIT_L(0); PG8_MMA(0, 0, At, B0); PG8_BAR; PG8_SCHED;
            PG8_LDB(B1, 1, 1); PG8_STAGE(PG8_SB(1, 0), b3, voffB);
            PG8_BAR; PG8_WAIT_L(0); PG8_MMA(0, 1, At, B1); PG8_BAR;
            PG8_LDA(At, 1, 1); PG8_STAGE(PG8_SA(1, 0), a3, voffA);
            PG8_BAR; PG8_WAIT_L(0); PG8_MMA(1, 0, At, B0); PG8_BAR; PG8_SCHED;
            PG8_STAGE(PG8_SB(1, 1), b3 + hstep, voffB);
            PG8_WAIT_V(6); PG8_BAR; PG8_MMA(1, 1, At, B1); PG8_BAR;
            }
        }
        if constexpr (ALIGN_EPI) { if (wr == 0) PG8_BAR; }
        if constexpr (!Epi::AFTER_DRAIN) { E(acc, cur, wr, wc, fr, fq); S.done(cur); }
        if (!has_next) break;
#pragma unroll
        for (int a = 0; a < 2; ++a)
#pragma unroll
            for (int b = 0; b < 2; ++b)
#pragma unroll
                for (int m = 0; m < 4; ++m)
#pragma unroll
                    for (int n = 0; n < 2; ++n) acc[a][b][m][n] = (f32x4){0.f, 0.f, 0.f, 0.f};
        cur = nxt; cA = nA; cB = nB; ++ui;
        if constexpr (ALIGN_EPI) { if (wr == 1) PG8_BAR; }
    }
    PG8_WAIT_V(0);
    if constexpr (!ALIGN_EPI) { if (wr == 0) PG8_BAR; }
    PG8_BAR;
    if constexpr (Epi::AFTER_DRAIN) { E.fused(acc, cur, wr, wc, fr, fq, lds, wid, lane); S.done(cur); }
#undef PG8_SA
#undef PG8_SB
#undef PG8_STAGE
#undef PG8_LDA
#undef PG8_LDB
#undef PG8_MMA
#undef PG8_WAIT_V
#undef PG8_WAIT_L
#undef PG8_BAR
#undef PG8_SCHED
}
}

#include <hip/hip_bf16.h>
#include <cmath>
namespace attn_body {
using bf16=__hip_bfloat16;
using bf16x8=__attribute__((ext_vector_type(8)))short;
using s16x4=__attribute__((ext_vector_type(4)))short;
using f32x16=__attribute__((ext_vector_type(16)))float;
using u32x4=__attribute__((ext_vector_type(4)))unsigned;
constexpr int BATCH=2,NHEAD=16,SEQ=8192,D=64,DM=NHEAD*D;
constexpr int NW=8,QBLK=32,QB=QBLK*NW,KVBLK=64,NQB=SEQ/QB;
constexpr int ATTN_PITCH=DM, ATTN_UNIT_ROWS=QB;
__device__ __forceinline__ int crow(int r,int hi){return (r&3)+8*(r>>2)+4*hi;}
#define SBAR() __builtin_amdgcn_sched_barrier(0)
__device__ __forceinline__ void cmask(f32x16&p0,f32x16&p1,int jb,int qrel,int hi){
  const float NEG=-INFINITY; int kb=64*jb+4*hi;
  #pragma unroll
  for(int r=0;r<16;++r){int kv=kb+(r&3)+8*(r>>2); if(kv>qrel)p0[r]=NEG; if(kv+32>qrel)p1[r]=NEG;}
}

constexpr int NSLOT=3, SLOTB=8192;
constexpr int LDS_K=0, LDS_V=NSLOT*SLOTB, LDS_WS=3*NSLOT*SLOTB, LDS_OST=LDS_WS+NW*64*4, LDS_BYTES=LDS_OST+NW*4096;
constexpr float C2=0.125f*1.4426950408889634f;
__device__ __forceinline__ void glds16(const void*gsrc,unsigned lds_dst){unsigned keep;
  asm volatile("s_mov_b32 %0, m0\n\ts_mov_b32 m0, %2\n\ts_nop 0\n\tglobal_load_lds_dwordx4 %1, off\n\ts_mov_b32 m0, %0":"=&s"(keep):"v"(gsrc),"s"(lds_dst):"memory");}
__device__ __forceinline__ float max3f(float a,float b,float c){float r;asm("v_max3_f32 %0, %1, %2, %3":"=v"(r):"v"(a),"v"(b),"v"(c));return r;}
__device__ __forceinline__ float max2f(float a,float b){float r;asm("v_max_f32_e32 %0, %1, %2":"=v"(r):"v"(a),"v"(b));return r;}
__device__ __forceinline__ float fadd_s(float a,float b){float r;asm("v_add_f32_e32 %0, %1, %2":"=v"(r):"v"(a),"v"(b));return r;}
__device__ __forceinline__ float fsub_s(float a,float b){float r;asm("v_sub_f32_e32 %0, %1, %2":"=v"(r):"v"(a),"v"(b));return r;}
typedef float f32x2_t __attribute__((ext_vector_type(2))); typedef __bf16 bf16x2_t __attribute__((ext_vector_type(2)));
__device__ __forceinline__ unsigned cvtpk_s(float lo,float hi){f32x2_t v={lo,hi};bf16x2_t b=__builtin_convertvector(v,bf16x2_t);return __builtin_bit_cast(unsigned,b);}
#define WAIT_BAR(N) asm volatile("s_waitcnt vmcnt(" #N ") lgkmcnt(0)\n\ts_barrier":::"memory")

__device__ __forceinline__ void qkt(f32x16&p0,f32x16&p1,const char*Kslot,const bf16x8*qr,const f32x16&negm,int r32,int hi){
  const char*kb=Kslot+hi*1024+r32*16;
  #pragma unroll
  for(int d0=0;d0<4;++d0){
    const bf16x8 b0=*reinterpret_cast<const bf16x8*>(kb+d0*2048);
    const bf16x8 b1=*reinterpret_cast<const bf16x8*>(kb+d0*2048+512);
    if(d0==0){p0=__builtin_amdgcn_mfma_f32_32x32x16_bf16(b0,qr[0],negm,0,0,0);p1=__builtin_amdgcn_mfma_f32_32x32x16_bf16(b1,qr[0],negm,0,0,0);}
    else{p0=__builtin_amdgcn_mfma_f32_32x32x16_bf16(b0,qr[d0],p0,0,0,0);p1=__builtin_amdgcn_mfma_f32_32x32x16_bf16(b1,qr[d0],p1,0,0,0);}}
}
typedef __attribute__((address_space(3))) const char* lds_cptr;
typedef short v4i16_t __attribute__((ext_vector_type(4)));
__device__ __forceinline__ void kload8(bf16x8*kf,lds_cptr kp){
  kf[0]=*(const __attribute__((address_space(3))) bf16x8*)(kp);      kf[1]=*(const __attribute__((address_space(3))) bf16x8*)(kp+512);
  kf[2]=*(const __attribute__((address_space(3))) bf16x8*)(kp+2048); kf[3]=*(const __attribute__((address_space(3))) bf16x8*)(kp+2560);
  kf[4]=*(const __attribute__((address_space(3))) bf16x8*)(kp+4096); kf[5]=*(const __attribute__((address_space(3))) bf16x8*)(kp+4608);
  kf[6]=*(const __attribute__((address_space(3))) bf16x8*)(kp+6144); kf[7]=*(const __attribute__((address_space(3))) bf16x8*)(kp+6656);
}
__device__ __forceinline__ void kload2(bf16x8*kf,lds_cptr kp,int j){ kf[2*j]=*(const __attribute__((address_space(3))) bf16x8*)(kp+j*2048); kf[2*j+1]=*(const __attribute__((address_space(3))) bf16x8*)(kp+j*2048+512); }
__device__ __forceinline__ void kload2p(bf16x8*kf,lds_cptr kp,int jsrc,int jdst){ kf[2*jdst]=*(const __attribute__((address_space(3))) bf16x8*)(kp+jsrc*2048); kf[2*jdst+1]=*(const __attribute__((address_space(3))) bf16x8*)(kp+jsrc*2048+512); }
__device__ __forceinline__ s16x4 vtr(lds_cptr p){ return __builtin_bit_cast(s16x4,__builtin_amdgcn_ds_read_tr16_b64_v4i16((__attribute__((address_space(3))) v4i16_t*)p)); }
__device__ __forceinline__ float rowmax(const f32x16&p0,const f32x16&p1){
  float a=max3f(p0[0],p0[1],p1[0]),b=max3f(p0[2],p0[3],p1[1]);a=max3f(a,p1[2],p1[3]);
  #pragma unroll
  for(int r=4;r<16;r+=4){a=max3f(a,p0[r],p0[r+1]);b=max3f(b,p0[r+2],p0[r+3]);a=max3f(a,p1[r],p1[r+1]);b=max3f(b,p1[r+2],p1[r+3]);}
  const float m=max2f(a,b);
  auto rr=__builtin_amdgcn_permlane32_swap(__float_as_uint(m),__float_as_uint(m),false,false);
  return max2f(__uint_as_float(rr[0]),__uint_as_float(rr[1]));
}
__device__ __forceinline__ void pv(f32x16*o,int vb,bf16x8 pa0,bf16x8 pa1,bf16x8 pa2,bf16x8 pa3){
  #pragma unroll
  for(int d0=0;d0<4;++d0){s16x4 lo[4],hi[4];
    #pragma unroll
    for(int ks=0;ks<4;++ks){
      asm volatile("ds_read_b64_tr_b16 %0,%1 offset:%c2":"=&v"(lo[ks]):"v"(vb),"i"(d0*4096+ks*1024):"memory");
      asm volatile("ds_read_b64_tr_b16 %0,%1 offset:%c2":"=&v"(hi[ks]):"v"(vb),"i"(d0*4096+ks*1024+512):"memory");}
    asm volatile("s_waitcnt lgkmcnt(0)":::"memory");SBAR();
    #define PK(k) (bf16x8){lo[k][0],lo[k][1],lo[k][2],lo[k][3],hi[k][0],hi[k][1],hi[k][2],hi[k][3]}
    o[d0]=__builtin_amdgcn_mfma_f32_32x32x16_bf16(pa0,PK(0),o[d0],0,0,0);
    o[d0]=__builtin_amdgcn_mfma_f32_32x32x16_bf16(pa1,PK(1),o[d0],0,0,0);
    o[d0]=__builtin_amdgcn_mfma_f32_32x32x16_bf16(pa2,PK(2),o[d0],0,0,0);
    o[d0]=__builtin_amdgcn_mfma_f32_32x32x16_bf16(pa3,PK(3),o[d0],0,0,0);
    #undef PK
  }
}

#ifndef ATTN_STORE16
#define ATTN_STORE16(p,v) (*(u32x4*)(p)=(v))
#endif
template<int THRL> __device__ __forceinline__ void attn_unit(int b,int h,int qb,const bf16*Q,const bf16*__restrict__ K,const bf16*__restrict__ V,bf16*O,char*shm,const bool comb,const float lam,const int tid_in){
  int tid_l=tid_in; asm volatile("":"+v"(tid_l)); const int tid=tid_l,lane=tid&63,r32=lane&31,hi=lane>>5; const int wid=__builtin_amdgcn_readfirstlane(tid>>6);
  const long rowbase=(long)b*SEQ; const int q0=qb*QB;
  const bf16*Qw=Q+(rowbase+q0+wid*QBLK)*DM+h*D;
  const bf16*Kh=K+rowbase*DM+h*D,*Vh=V+rowbase*DM+h*D;
  const unsigned lds0=(unsigned)(uintptr_t)shm;
  float*wsf=(float*)(shm+LDS_WS)+wid*64;
  const bf16*ksrc=Kh+(long)lane*DM+wid*8;
  const bf16*vsrc=Vh+(long)(16*(wid&3)+(lane>>2))*DM+(wid>>2)*32+(lane&3)*8;
  const unsigned kdst=lds0+LDS_K+wid*1024, vdst=lds0+LDS_V+wid*1024;
  #define DMA_K(t,slot) glds16(ksrc+(long)(t)*KVBLK*DM,(unsigned)__builtin_amdgcn_readfirstlane(kdst+(slot)))
  #define DMA_V(t,slot) do{ glds16(vsrc+(long)(t)*KVBLK*DM,(unsigned)__builtin_amdgcn_readfirstlane(vdst+2*(slot))); glds16(vsrc+64+(long)(t)*KVBLK*DM,(unsigned)__builtin_amdgcn_readfirstlane(vdst+8192+2*(slot))); }while(0)
  const int vb0=(int)(lds0+LDS_V)+((lane>>4)&1)*32+(lane&3)*8+(4*hi+((lane&15)>>2))*64;
  const char*Kbase=shm+LDS_K; bf16x8 kf[4];
  const lds_cptr shm3=(lds_cptr)shm; const lds_cptr kp0=shm3+LDS_K+hi*1024+r32*16; const lds_cptr vp0=shm3+LDS_V+((lane>>4)&1)*32+(lane&3)*8+(4*hi+((lane&15)>>2))*64;
  const int NT=(q0+QB)/KVBLK;
  DMA_K(0,0);DMA_V(0,0);DMA_K(1,SLOTB);
  bf16x8 qr[4];
  #pragma unroll
  for(int d0=0;d0<4;++d0)qr[d0]=*reinterpret_cast<const bf16x8*>(&Qw[(long)r32*DM+d0*16+hi*8]);
  float mhat=0.f,l_reg=0.f;f32x16 o[4];o[0]=f32x16{};o[1]=f32x16{};o[2]=f32x16{};o[3]=f32x16{};f32x16 negm=f32x16{};asm volatile("":"+v"(negm));
  const int qrel=wid*QBLK+r32;
  #define CMASK(P0,P1,t) do{int jb_=(t)-(NT-4); if(jb_>=0)cmask(P0,P1,jb_,qrel,hi);}while(0)
  bool resc=false;
  #define START(P0,P1) do{ const float rm=rowmax(P0,P1); resc=false; \
    { const float dl=rm; mhat=fadd_s(mhat,dl); \
      _Pragma("unroll") for(int r=0;r<16;++r){P0[r]=fsub_s(P0[r],dl);P1[r]=fsub_s(P1[r],dl);} \
      _Pragma("unroll") for(int r=0;r<16;++r)negm[r]=-mhat; asm volatile("":"+v"(negm)); } \
    _Pragma("unroll") for(int r=0;r<16;++r)P0[r]=__builtin_amdgcn_exp2f(P0[r]); }while(0)
  #define RESC() do{ if(resc){ asm volatile("s_waitcnt lgkmcnt(0)":::"memory"); \
      _Pragma("unroll") for(int d_=0;d_<4;++d_) _Pragma("unroll") for(int r=0;r<16;++r)o[d_][r]*=wsf[crow(r,hi)]; } }while(0)
  f32x16 pA0,pA1,pB0,pB1;
  int sl_prev=0,sl_cur=0,sl_next=SLOTB;
  #define ROT() do{sl_prev=sl_cur;sl_cur=sl_next;sl_next=(sl_next==(NSLOT-1)*SLOTB)?0:sl_next+SLOTB;}while(0)
  DMA_K(2,2*SLOTB);
  WAIT_BAR(3);
  qkt(pA0,pA1,Kbase,qr,negm,r32,hi);asm volatile("s_nop 15\n\ts_nop 7":"+v"(pA0),"+v"(pA1));CMASK(pA0,pA1,0);
  START(pA0,pA1);
  _Pragma("unroll") for(int r=0;r<16;++r)pA1[r]=__builtin_amdgcn_exp2f(pA1[r]);
  WAIT_BAR(0);
  DMA_V(1,SLOTB);
  ROT();
  kload2p(kf,kp0+sl_cur,0,0); kload2p(kf,kp0+sl_cur,1,1);
  WAIT_BAR(2);
  s16x4 f0l,f0h,f1l,f1h,f2l,f2h,f3l,f3h; u32x4 pw0,pw1,pw2,pw3;
  #define PKW(P,B) cvtpk_s(P[B],P[B+1])
  #define PAF(k) __builtin_bit_cast(bf16x8,pw##k)
  #define VFRF(F) (bf16x8){F##l[0],F##l[1],F##l[2],F##l[3],F##h[0],F##h[1],F##h[2],F##h[3]}
  #define VRDF(F,d0,ks) do{ F##l=vtr(vp_+((d0)*4096+(ks)*1024)); F##h=vtr(vp_+((d0)*4096+(ks)*1024+512)); }while(0)
  #define PIN(x) asm volatile(""::"v"(x))
  #define MX3(a,b,c) __builtin_fmaxf(__builtin_fmaxf((a),(b)),(c))
  #define GAPA(MF,A0,A1,A2,A3,W0,W1,PW) do{ MF; sacc+=A0; sacc+=A1; sacc+=A2; sacc+=A3; PIN(sacc); W0; W1; PIN(PW); SBAR(); }while(0)
  #define EX(v) __builtin_amdgcn_exp2f(v)
  #define GAPB2(MF,X,B) do{ MF; X[B]=EX(X[B]); X[B+1]=EX(X[B+1]); PIN(X); SBAR(); }while(0)
  #define GAPB3(MF,X,B) do{ MF; X[B]=EX(X[B]); X[B+1]=EX(X[B+1]); X[B+2]=EX(X[B+2]); PIN(X); SBAR(); }while(0)
  #define KRD(G,j) do{ if(G){ kload2p(kf,kp0+sl_next,j,j); SBAR(); } }while(0)
  #define KRA(js,jd) do{ kload2p(kf,kp0+sl_cur,js,jd); SBAR(); }while(0)
  #define MF_ __builtin_amdgcn_mfma_f32_32x32x16_bf16
  #define STEP(C0,C1,P0,P1,t,GK,GV,GL) do{ SBAR(); \
    if(GK){DMA_K((t)+2,sl_prev);} \
    const lds_cptr vp_=vp0+2*sl_prev; \
    VRDF(f0,0,0); SBAR(); float sacc=(P0[0]+P0[1]); \
    GAPA(C0=MF_(kf[0],qr[0],negm,0,0,0), P0[2],P0[3],P0[4],P0[5],     pw0[0]=PKW(P0,0), pw0[1]=PKW(P0,2), pw0); \
    VRDF(f1,1,0); SBAR(); GAPA(C1=MF_(kf[1],qr[0],negm,0,0,0), P0[6],P0[7],P0[8],P0[9],     pw0[2]=PKW(P0,4), pw0[3]=PKW(P0,6), pw0); KRA(2,0); \
    VRDF(f2,2,0); SBAR(); GAPA(C0=MF_(kf[2],qr[1],C0,0,0,0),   P0[10],P0[11],P0[12],P0[13], pw1[0]=PKW(P0,8), pw1[1]=PKW(P0,10), pw1); \
    VRDF(f3,3,0); SBAR(); GAPA(C1=MF_(kf[3],qr[1],C1,0,0,0),   P0[14],P0[15],P1[0],P1[1],   pw1[2]=PKW(P0,12),pw1[3]=PKW(P0,14), pw1); KRA(3,1); \
    GAPA(C0=MF_(kf[0],qr[2],C0,0,0,0),   P1[2],P1[3],P1[4],P1[5],     pw2[0]=PKW(P1,0), pw2[1]=PKW(P1,2), pw2); \
    GAPA(C1=MF_(kf[1],qr[2],C1,0,0,0),   P1[6],P1[7],P1[8],P1[9],     pw2[2]=PKW(P1,4), pw2[3]=PKW(P1,6), pw2); \
    GAPA(C0=MF_(kf[2],qr[3],C0,0,0,0),   P1[10],P1[11],P1[12],P1[13], pw3[0]=PKW(P1,8), pw3[1]=PKW(P1,10), pw3); \
    GAPA(C1=MF_(kf[3],qr[3],C1,0,0,0),   P1[14],P1[15],0.f,0.f,       pw3[2]=PKW(P1,12),pw3[3]=PKW(P1,14), pw3); \
    l_reg+=sacc; \
    if(GV){DMA_V((t)+1,sl_next);} \
    CMASK(C0,C1,t); \
      \
      \
    SBAR(); \
    float mxa_,mxb_; \
    o[0]=MF_(PAF(0),VFRF(f0),o[0],0,0,0); mxa_=MX3(C0[0],C0[1],C1[0]); mxb_=MX3(C0[2],C0[3],C1[1]); mxa_=MX3(mxa_,C1[2],C1[3]); mxa_=MX3(mxa_,C0[4],C0[5]); mxb_=MX3(mxb_,C0[6],C0[7]); PIN(mxa_); PIN(mxb_); SBAR(); VRDF(f0,0,1); SBAR(); \
    o[1]=MF_(PAF(0),VFRF(f1),o[1],0,0,0); mxa_=MX3(mxa_,C1[4],C1[5]); mxb_=MX3(mxb_,C1[6],C1[7]); mxa_=MX3(mxa_,C0[8],C0[9]); mxb_=MX3(mxb_,C0[10],C0[11]); mxa_=MX3(mxa_,C1[8],C1[9]); PIN(mxa_); PIN(mxb_); SBAR(); VRDF(f1,1,1); SBAR(); \
    o[2]=MF_(PAF(0),VFRF(f2),o[2],0,0,0); mxb_=MX3(mxb_,C1[10],C1[11]); mxa_=MX3(mxa_,C0[12],C0[13]); mxb_=MX3(mxb_,C0[14],C0[15]); mxa_=MX3(mxa_,C1[12],C1[13]); mxb_=MX3(mxb_,C1[14],C1[15]); PIN(mxa_); PIN(mxb_); SBAR(); VRDF(f2,2,1); SBAR(); \
    o[3]=MF_(PAF(0),VFRF(f3),o[3],0,0,0); \
    { float rm=__builtin_fmaxf(mxa_,mxb_); { auto rr=__builtin_amdgcn_permlane32_swap(__float_as_uint(rm),__float_as_uint(rm),false,false); rm=__builtin_fmaxf(__uint_as_float(rr[0]),__uint_as_float(rr[1])); } \
      resc=false; \
      if(__builtin_expect(__any(rm>(float)THRL),0)){ const float dl=__builtin_fmaxf(rm,0.f); mhat+=dl; \
        _Pragma("unroll") for(int r=0;r<16;++r){C0[r]-=dl;C1[r]-=dl;} \
        _Pragma("unroll") for(int r=0;r<16;++r)negm[r]=-mhat; asm volatile("":"+v"(negm)); \
        const float f=__builtin_amdgcn_exp2f(-dl); l_reg*=f; if(hi==0)wsf[r32]=f; resc=true; } } \
    SBAR(); VRDF(f3,3,1); SBAR(); \
    GAPB3(o[0]=MF_(PAF(1),VFRF(f0),o[0],0,0,0), C0,0);  VRDF(f0,0,2); SBAR(); \
    GAPB3(o[1]=MF_(PAF(1),VFRF(f1),o[1],0,0,0), C0,3);  VRDF(f1,1,2); SBAR(); \
    GAPB3(o[2]=MF_(PAF(1),VFRF(f2),o[2],0,0,0), C0,6);  VRDF(f2,2,2); SBAR(); \
    GAPB3(o[3]=MF_(PAF(1),VFRF(f3),o[3],0,0,0), C0,9);  VRDF(f3,3,2); SBAR(); \
    GAPB3(o[0]=MF_(PAF(2),VFRF(f0),o[0],0,0,0), C0,12); VRDF(f0,0,3); SBAR(); \
    do{ o[1]=MF_(PAF(2),VFRF(f1),o[1],0,0,0); C0[15]=EX(C0[15]); C1[0]=EX(C1[0]); C1[1]=EX(C1[1]); PIN(C0); PIN(C1); SBAR(); }while(0); VRDF(f1,1,3); SBAR(); \
    GAPB3(o[2]=MF_(PAF(2),VFRF(f2),o[2],0,0,0), C1,2);  VRDF(f2,2,3); SBAR(); \
    GAPB3(o[3]=MF_(PAF(2),VFRF(f3),o[3],0,0,0), C1,5);  VRDF(f3,3,3); SBAR(); \
    GAPB2(o[0]=MF_(PAF(3),VFRF(f0),o[0],0,0,0), C1,8); KRD(GL,0); \
    GAPB2(o[1]=MF_(PAF(3),VFRF(f1),o[1],0,0,0), C1,10); KRD(GL,1); \
    GAPB2(o[2]=MF_(PAF(3),VFRF(f2),o[2],0,0,0), C1,12); \
    GAPB2(o[3]=MF_(PAF(3),VFRF(f3),o[3],0,0,0), C1,14); \
    }while(0)
  int t=1;
  #undef CMASK
  #define CMASK(P0,P1,t) do{}while(0)
  for(;t+5<NT;t+=2){
    STEP(pB0,pB1,pA0,pA1,t,true,true,true);     WAIT_BAR(2); RESC(); ROT();
    STEP(pA0,pA1,pB0,pB1,t+1,true,true,true);   WAIT_BAR(2); RESC(); ROT();
  }
  #undef CMASK
  #define CMASK(P0,P1,t) do{int jb_=(t)-(NT-4); if(jb_>=0)cmask(P0,P1,jb_,qrel,hi);}while(0)
  #define ENDW(tt) do{ if((tt)+2<NT){WAIT_BAR(2);} else {WAIT_BAR(0);} }while(0)
  for(;t+1<NT;t+=2){
    STEP(pB0,pB1,pA0,pA1,t,(t+2<NT),(t+1<NT),(t+1<NT));       ENDW(t);   RESC(); ROT();
    STEP(pA0,pA1,pB0,pB1,t+1,(t+3<NT),(t+2<NT),(t+2<NT));     ENDW(t+1); RESC(); ROT();
  }
  STEP(pB0,pB1,pA0,pA1,NT-1,false,false,false); RESC();
  { float sacc=pB0[0]+pB0[1]; _Pragma("unroll") for(int r=2;r<16;++r)sacc+=pB0[r]; _Pragma("unroll") for(int r=0;r<16;++r)sacc+=pB1[r]; l_reg+=sacc;
    pw0=(u32x4){PKW(pB0,0),PKW(pB0,2),PKW(pB0,4),PKW(pB0,6)};pw1=(u32x4){PKW(pB0,8),PKW(pB0,10),PKW(pB0,12),PKW(pB0,14)};pw2=(u32x4){PKW(pB1,0),PKW(pB1,2),PKW(pB1,4),PKW(pB1,6)};pw3=(u32x4){PKW(pB1,8),PKW(pB1,10),PKW(pB1,12),PKW(pB1,14)};
    SBAR(); pv(o,vb0+2*sl_cur,PAF(0),PAF(1),PAF(2),PAF(3)); }
  #undef PKW
  #undef PAF
  #undef VFRF
  #undef VRDF
  #undef MF_
  #undef PIN
  #undef MX3
  #undef GAPA
  #undef GAPB2
  #undef GAPB3
  #undef EX
  #undef KRD
  #undef KRA
  #undef STEP
  #undef ENDW
  {auto rr=__builtin_amdgcn_permlane32_swap(__float_as_uint(l_reg),__float_as_uint(l_reg),false,false);l_reg=__uint_as_float(rr[0])+__uint_as_float(rr[1]);}
  if(hi==0)wsf[32+r32]=l_reg;asm volatile("s_waitcnt lgkmcnt(0)":::"memory");
  float rli[16];
  #pragma unroll
  for(int r=0;r<16;++r)rli[r]=__builtin_amdgcn_rcpf(wsf[32+crow(r,hi)]);
  bf16*Ow=O+(rowbase+q0+wid*QBLK)*DM+h*D;
  u32x4 prevo[2][4];
  if(comb){
    #pragma unroll
    for(int half=0;half<2;++half)
      #pragma unroll
      for(int i=0;i<4;++i)prevo[half][i]=__builtin_nontemporal_load((const u32x4*)(Ow+(long)(i*8+(lane>>3))*DM+half*64+(lane&7)*8)); }
  { bf16*stg=(bf16*)(shm+LDS_OST)+wid*2048;
    #pragma unroll
    for(int half=0;half<2;++half){
      #pragma unroll
      for(int r=0;r<16;++r){const int orow=crow(r,hi);
        #pragma unroll
        for(int d0=0;d0<2;++d0)stg[orow*64+d0*32+r32]=__float2bfloat16(o[2*half+d0][r]*rli[r]);}
      asm volatile("s_waitcnt lgkmcnt(0)":::"memory");
      #pragma unroll
      for(int i=0;i<4;++i){const int row=i*8+(lane>>3),ch=lane&7; u32x4 v=*(const u32x4*)(stg+row*64+ch*8);
        if(comb){ const u32x4 pv_=prevo[half][i];
          _Pragma("unroll") for(int e=0;e<4;++e){ const float c0=__uint_as_float(v[e]<<16),c1=__uint_as_float(v[e]&0xffff0000u),p0_=__uint_as_float(pv_[e]<<16),p1_=__uint_as_float(pv_[e]&0xffff0000u); v[e]=cvtpk_s(p0_-lam*c0,p1_-lam*c1);} }
        ATTN_STORE16(Ow+(long)row*DM+half*64+ch*8,v);}
      asm volatile("s_waitcnt lgkmcnt(0)":::"memory");
    } }
  asm volatile("s_waitcnt lgkmcnt(0)\n\ts_barrier":::"memory");
  #undef DMA_K
  #undef DMA_V
  #undef CMASK
  #undef START
  #undef RESC
  #undef ROT
}
constexpr int ATTN_LDS_BYTES=LDS_BYTES;
#undef SBAR
#undef WAIT_BAR
}

#define GAS __attribute__((address_space(1)))
#define LAS __attribute__((address_space(3)))
typedef unsigned short bf16;
typedef unsigned v4u __attribute__((ext_vector_type(4)));
typedef float f32x4 __attribute__((ext_vector_type(4)));
typedef short bf16x8 __attribute__((ext_vector_type(8)));
typedef GAS unsigned gu32;
typedef GAS unsigned long long gu64;
#define RLX_AGENT __ATOMIC_RELAXED, __HIP_MEMORY_SCOPE_AGENT
#define LDS_WAIT() asm volatile("s_waitcnt lgkmcnt(0)" ::: "memory")
#define VM_WAIT() asm volatile("s_waitcnt vmcnt(0)" ::: "memory")
__device__ __forceinline__ unsigned long long rt() { return __builtin_amdgcn_s_memrealtime(); }

#define XB_TMO      128
#define XB_XCNT(j)  (256  + 64 * (j))
#define XB_XSUB(j)  (1280 + 64 * (j))
#define XB_XGEN(j)  (2304 + 64 * (j))
#define XB_TOP      3328
#define XB_TOPGEN   3392
#define XCD_BAR_WORDS 3456
#define XB_SPIN_CAP (1u << 18)

__device__ __forceinline__ unsigned xb_ld(unsigned* p)              { return __hip_atomic_load(p, __ATOMIC_RELAXED, __HIP_MEMORY_SCOPE_AGENT); }
__device__ __forceinline__ unsigned xb_add(unsigned* p, unsigned v) { return __hip_atomic_fetch_add(p, v, __ATOMIC_RELAXED, __HIP_MEMORY_SCOPE_AGENT); }
__device__ __forceinline__ unsigned xb_xcc_id() { return (unsigned)__builtin_amdgcn_s_getreg((3 << 11) | 20) & 0xFu; }
#define XB_SPIN(cond, bar) do { unsigned _sp = 0; while (cond) { __builtin_amdgcn_s_sleep(1); \
    if ((++_sp & 255u) == 0u) { if (xb_ld(&(bar)[XB_TMO])) break; if (_sp > XB_SPIN_CAP) { atomicAdd(&(bar)[XB_TMO], 1u); break; } } } } while (0)

struct XcdBarrier {
    unsigned* bar; unsigned x;
    volatile LAS unsigned* st;
};

__device__ __forceinline__ XcdBarrier xcd_barrier_post(unsigned* bar, volatile LAS unsigned* st) {
    XcdBarrier b; b.bar = bar; b.x = xb_xcc_id(); b.st = st;
    if (threadIdx.x == 0) (void)xb_add(&bar[XB_XCNT(b.x)], 1u);
    return b;
}
__device__ __forceinline__ void xcd_barrier_complete(unsigned* bar, unsigned x, unsigned& nloc, unsigned& nx) {
    const unsigned G = gridDim.x * gridDim.y * gridDim.z;
    unsigned sum, cnt, mine, sp = 0u;
    for (;;) {
        sum = 0u; cnt = 0u; mine = 0u;
#pragma unroll
        for (unsigned j = 0; j < 16; ++j) { const unsigned c = xb_ld(&bar[XB_XCNT(j)]); sum += c; cnt += (c > 0u) ? 1u : 0u; mine = (j == x) ? c : mine; }
        if (sum == G) break;
        __builtin_amdgcn_s_sleep(1);
        if ((++sp & 255u) == 0u) { if (xb_ld(&bar[XB_TMO])) break; if (sp > XB_SPIN_CAP) { atomicAdd(&bar[XB_TMO], 1u); break; } }
    }
    nloc = mine > 0u ? mine : 1u; nx = cnt > 0u ? cnt : 1u;
}

__device__ __forceinline__ void xcd_barrier(const XcdBarrier& b) {
    asm volatile("s_waitcnt vmcnt(0)" ::: "memory");
    __syncthreads();
    if (threadIdx.x == 0) {
        unsigned* bar = b.bar;
        __builtin_amdgcn_s_waitcnt(0);
        unsigned nloc = b.st[0], nx = b.st[1];
        if (nloc == 0u) { xcd_barrier_complete(bar, b.x, nloc, nx); b.st[0] = nloc; b.st[1] = nx; }
        const unsigned old = xb_add(&bar[XB_XSUB(b.x)], 1u);
        const unsigned gen = old / nloc;
        if (old + 1u == (gen + 1u) * nloc) {
            __builtin_amdgcn_fence(__ATOMIC_RELEASE, "agent");
            asm volatile("s_waitcnt vmcnt(0)" ::: "memory");
            const unsigned og = xb_add(&bar[XB_TOP], 1u);
            const unsigned tg = og / nx;
            if (og + 1u == (tg + 1u) * nx) xb_add(&bar[XB_TOPGEN], 1u);
            else XB_SPIN(xb_ld(&bar[XB_TOPGEN]) == tg, bar);
            __builtin_amdgcn_fence(__ATOMIC_ACQUIRE, "agent");
            xb_add(&bar[XB_XGEN(b.x)], 1u);
            asm volatile("s_waitcnt vmcnt(0)" ::: "memory");
        } else {
            XB_SPIN(xb_ld(&bar[XB_XGEN(b.x)]) == gen, bar);
            __builtin_amdgcn_fence(__ATOMIC_ACQUIRE, "agent");
            asm volatile("s_waitcnt vmcnt(0)" ::: "memory");
        }
    }
    __syncthreads();
}

constexpr int NWAVES = 8, NTHREADS = 512;
constexpr int LDS_BYTES = 159744;
constexpr int LDS_CTL0 = 155648, LDS_MISC = LDS_CTL0 + 320;
typedef unsigned v2u __attribute__((ext_vector_type(2)));
typedef float f32x16 __attribute__((ext_vector_type(16)));

constexpr size_t WS_CTLZERO = 1 * MiB;
constexpr int CW_BAR = 4096;
constexpr size_t WS_FLAGS = 32 * 1024;
constexpr size_t WS_RFLAGS = 48 * 1024;
constexpr size_t WS_FCNT = 52 * 1024;
constexpr size_t WS_MOD = 64 * 1024;
constexpr size_t WS_LAM = 192 * 1024;
constexpr size_t WS_RSS = 256 * 1024;
constexpr size_t WS_RSS0 = 512 * 1024;
constexpr size_t WS_BIASIN = 1 * MiB;
constexpr size_t WS_BIASUP = 1 * MiB + 64 * 1024;
constexpr size_t WS_AGG = 1 * MiB + 512 * 1024;
constexpr size_t WS_COS = 2 * MiB, WS_SIN = 4 * MiB;
constexpr size_t WS_WA = 6 * MiB;
constexpr size_t WS_WOUT = 20 * MiB;
constexpr size_t WS_WDOWN = 22 * MiB;
constexpr size_t WS_RGA = 28 * MiB;
constexpr size_t WS_RGI = 28 * MiB + 256 * 1024;

struct Params {
    const float *x, *c; const int* pos;
    const float *w_mod, *b_mod, *g_mix, *w_in, *lq1, *lk1, *lq2, *lk2, *g_subln, *conv_rnn_w, *conv_rnn_b, *w_rg_a, *b_rg_a, *w_rg_i, *b_rg_i, *lam_rg, *w_out, *g_ffn, *w_up, *conv_ffn_w, *conv_ffn_b, *w_down, *g_final;
    float* out; unsigned char* ws; int ph_lo, ph_hi;
};


typedef __attribute__((address_space(4))) const unsigned char* kaptr_t;
template <class T> __device__ __forceinline__ T ka_load(kaptr_t ka, size_t off) { asm volatile("" : "+s"(ka)); return *(const __attribute__((address_space(4))) T*)(ka + off); }
#define PP(f) ka_load<decltype(Params::f)>(ka, offsetof(Params, f))
__device__ __forceinline__ int cur_tid(int wave0) { unsigned z = 0u; asm volatile("" : "+v"(z)); return wave0 * 64 + (int)__builtin_amdgcn_mbcnt_hi(~0u, __builtin_amdgcn_mbcnt_lo(~0u, z)); }
template <int CTRL> __device__ __forceinline__ float dpp_mov(float x) { return __int_as_float(__builtin_amdgcn_update_dpp(0, __float_as_int(x), CTRL, 0xf, 0xf, true)); }
__device__ __forceinline__ float rowsum16(float v) {
    v += dpp_mov<0x128>(v); v += dpp_mov<0x124>(v); v += dpp_mov<0x122>(v); v += dpp_mov<0x121>(v); return v; }
__device__ __forceinline__ float wsum64(float v) {
#pragma unroll
    for (int o = 1; o < 64; o <<= 1) v += __shfl_xor(v, o);
    return v;
}
__device__ __forceinline__ unsigned pkbf(float lo, float hi) { return pg8::cvt_pk_bf16(lo, hi); }
__device__ __forceinline__ float bflo(unsigned w) { return __uint_as_float(w << 16); }
__device__ __forceinline__ float bfhi(unsigned w) { return __uint_as_float(w & 0xffff0000u); }

template <int MAP> __device__ __forceinline__ int srccol(int n) {
    if (MAP == 0) return n;
    if (MAP == 1) {
        const int pn = n >> 8, p = n & 255;
        if (pn < 8) { const int bj = p >> 7, wc = (p >> 5) & 3, d = p & 31; return (pn >> 2) * 1024 + (4 * (pn & 3) + wc) * 64 + 32 * bj + d; }
        if (pn < 16) return n;
        if (pn < 24) return (p < 128 ? 4096 : 6144) + (pn - 16) * 128 + (p & 127);
        return 5120 + (pn - 24) * 256 + p;
    }
    if (MAP == 2) { const int pn = n >> 8, p = n & 255; return (p < 128 ? 0 : 3072) + pn * 128 + (p & 127); }
    return n;
}
constexpr int TR_LD = 68, TR_SCR_BYTES = 64 * TR_LD * 4;
template <int MAP> __device__ __forceinline__ void transpose_item(const float* __restrict__ W, int K, int ldw, int ndest, bf16* WT, LAS float* scr, int item, int lane) {
    const int nblk = ndest / 64, kb = item / nblk, nb = item % nblk, k0 = 64 * kb, n0 = 64 * nb;
    const int c4 = lane & 15, kr = lane >> 4;
    const int sc = srccol<MAP>(n0 + 4 * c4);
    f32x4 v[16];
#pragma unroll
    for (int i = 0; i < 16; ++i) v[i] = *(const f32x4*)(W + (size_t)(k0 + 4 * i + kr) * ldw + sc);
#pragma unroll
    for (int i = 0; i < 16; ++i) { const int k = 4 * i + kr; *(LAS f32x4*)(scr + k * TR_LD + ((4 * c4 + 4 * (k >> 3)) & 63)) = v[i]; }
    asm volatile("s_waitcnt lgkmcnt(0)" ::: "memory");
    const int c = lane & 7;
#pragma unroll
    for (int j = 0; j < 8; ++j) { const int n = (lane >> 3) + 8 * j; const LAS float* s = scr + (8 * c) * TR_LD + ((n + 4 * c) & 63);
        v4u o; o.x = pkbf(s[0 * TR_LD], s[1 * TR_LD]); o.y = pkbf(s[2 * TR_LD], s[3 * TR_LD]); o.z = pkbf(s[4 * TR_LD], s[5 * TR_LD]); o.w = pkbf(s[6 * TR_LD], s[7 * TR_LD]);
        *(v4u*)(WT + (size_t)(n0 + n) * K + k0 + 8 * c) = o; }
    asm volatile("s_waitcnt lgkmcnt(0)" ::: "memory");
}
template <int MAP> __device__ __forceinline__ int convert_w(const float* W, int K, int ldw, int ndest, bf16* WT, LAS float* scr, int gw, int NGW, int base, int lane) {
    const int nitems = (K / 64) * (ndest / 64);
    int first = (gw - base % NGW + NGW) % NGW;
    for (int it = first; it < nitems; it += NGW) transpose_item<MAP>(W, K, ldw, ndest, WT, scr, it, lane);
    return base + nitems;
}
__device__ __forceinline__ void bias_rows(const bf16* WT, int nrows, const float* sh0, const float* sh1, float* bias, int ldb, int gw, int NGW, int lane) {
    f32x4 a0[4], a1[4];
#pragma unroll
    for (int j = 0; j < 4; ++j) { a0[j] = *(const f32x4*)(sh0 + lane * 16 + 4 * j); a1[j] = *(const f32x4*)(sh1 + lane * 16 + 4 * j); }
    for (int n0 = gw; n0 < nrows; n0 += 4 * NGW) {
        v4u w0[4], w1[4];
#pragma unroll
        for (int q = 0; q < 4; ++q) { const int n = min(n0 + q * NGW, nrows - 1); w0[q] = *(const v4u*)(WT + (size_t)n * 1024 + lane * 16); w1[q] = *(const v4u*)(WT + (size_t)n * 1024 + lane * 16 + 8); }
#pragma unroll
        for (int q = 0; q < 4; ++q) {
            const int n = n0 + q * NGW;
            float s0 = 0.f, s1 = 0.f;
#pragma unroll
            for (int e = 0; e < 4; ++e) {
                const float wl = bflo(w0[q][e]), wh = bfhi(w0[q][e]), xl = bflo(w1[q][e]), xh = bfhi(w1[q][e]);
                s0 += wl * a0[e >> 1][(e & 1) * 2] + wh * a0[e >> 1][(e & 1) * 2 + 1] + xl * a0[2 + (e >> 1)][(e & 1) * 2] + xh * a0[2 + (e >> 1)][(e & 1) * 2 + 1];
                s1 += wl * a1[e >> 1][(e & 1) * 2] + wh * a1[e >> 1][(e & 1) * 2 + 1] + xl * a1[2 + (e >> 1)][(e & 1) * 2] + xh * a1[2 + (e >> 1)][(e & 1) * 2 + 1];
            }
            s0 = wsum64(s0); s1 = wsum64(s1);
            if (lane == 0 && n < nrows) { bias[n] = s0; bias[ldb + n] = s1; }
        }
    }
}

constexpr int RT_LD = 136, RT_B = 69632, RT_COMP = 139264, RT_HIN = 147456, RT_FOLD = 151552, RT_END = 155648;
__device__ __forceinline__ void rnn_stage_w(kaptr_t ka, int n, LAS unsigned char* lds, int tid) {
    const bf16* wa = (const bf16*)(PP(ws) + WS_RGA) + (size_t)n * 16384; const bf16* wi = (const bf16*)(PP(ws) + WS_RGI) + (size_t)n * 16384;
    LAS bf16* Bt = (LAS bf16*)(lds + RT_B);
    v4u v[8];
#pragma unroll
    for (int i = 0; i < 8; ++i) { const int it = tid + i * NTHREADS, row = it >> 4, cg = (it & 15) * 8; v[i] = *(const v4u*)((row < 128 ? wa : wi) + (size_t)(row & 127) * 128 + cg); }
#pragma unroll
    for (int i = 0; i < 8; ++i) { const int it = tid + i * NTHREADS, row = it >> 4, cg = (it & 15) * 8; *(LAS v4u*)(Bt + row * RT_LD + cg) = v[i]; }
}
template <bool PASS2> __device__ __forceinline__ void rnn_tile(kaptr_t ka, int l, int rt, int n, LAS unsigned char* lds, int tid, int wave, int lane,
                                                               const bf16* XR, const bf16* O, const bf16* SGA, const bf16* G2, bf16* MIX, float lam_os) {
    const int b = rt >> 5, t0 = (rt & 31) * 256; const size_t row0 = (size_t)rt * 256;
    LAS bf16* At = (LAS bf16*)lds; LAS bf16* Bt = (LAS bf16*)(lds + RT_B);
    {
        const float* cw = PP(conv_rnn_w) + (size_t)l * 4 * 1024 + n * 128; const float* cb = PP(conv_rnn_b) + l * 1024 + n * 128;
        const int cg = (tid & 15) * 8, r0 = (tid >> 4) * 8;
        v4u xv[11];
#pragma unroll
        for (int j = 0; j < 11; ++j) { const int tt = t0 + r0 - 3 + j; xv[j] = tt >= 0 ? *(const v4u*)(XR + (row0 + r0 - 3 + j) * 1024 + n * 128 + cg) : (v4u){0u, 0u, 0u, 0u}; }
        float w[4][8], bb[8];
#pragma unroll
        for (int j = 0; j < 4; ++j) { const f32x4 w0 = *(const f32x4*)(cw + j * 1024 + cg), w1 = *(const f32x4*)(cw + j * 1024 + cg + 4);
#pragma unroll
            for (int e = 0; e < 4; ++e) { w[j][e] = w0[e]; w[j][4 + e] = w1[e]; } }
        { const f32x4 b0 = *(const f32x4*)(cb + cg), b1 = *(const f32x4*)(cb + cg + 4);
#pragma unroll
          for (int e = 0; e < 4; ++e) { bb[e] = b0[e]; bb[4 + e] = b1[e]; } }
#pragma unroll
        for (int r = 0; r < 8; ++r) {
            float acc[8];
#pragma unroll
            for (int e = 0; e < 8; ++e) acc[e] = bb[e];
#pragma unroll
            for (int j = 0; j < 4; ++j) { const v4u x = xv[r + j];
                acc[0] += w[j][0] * bflo(x.x); acc[1] += w[j][1] * bfhi(x.x); acc[2] += w[j][2] * bflo(x.y); acc[3] += w[j][3] * bfhi(x.y);
                acc[4] += w[j][4] * bflo(x.z); acc[5] += w[j][5] * bfhi(x.z); acc[6] += w[j][6] * bflo(x.w); acc[7] += w[j][7] * bfhi(x.w); }
            v4u o; o.x = pkbf(acc[0], acc[1]); o.y = pkbf(acc[2], acc[3]); o.z = pkbf(acc[4], acc[5]); o.w = pkbf(acc[6], acc[7]);
            *(LAS v4u*)(At + (r0 + r) * RT_LD + cg) = o;
        }
    }
    __syncthreads();
    float nba_[4], nbi_[4], sp8l_[4];
#pragma unroll
    for (int cbk = 0; cbk < 4; ++cbk) { const int ch = l * 1024 + n * 128 + cbk * 32 + (lane & 31);
        const float lr = PP(lam_rg)[ch];
        nba_[cbk] = -1.4426950408889634f * PP(b_rg_a)[ch]; nbi_[cbk] = -1.4426950408889634f * PP(b_rg_i)[ch];
        sp8l_[cbk] = -8.0f * 1.4426950408889634f * ((lr > 0.f ? 0.f : -lr) + log1pf(__expf(-fabsf(lr)))); }
    f32x16 R[4], I[4];
    { const int r32 = lane & 31, hi = lane >> 5;
#pragma unroll
    for (int cbk = 0; cbk < 4; ++cbk) { R[cbk] = f32x16{}; I[cbk] = f32x16{}; }
#pragma unroll
    for (int s = 0; s < 8; ++s) {
        const bf16x8 af = *(const LAS bf16x8*)(At + (wave * 32 + r32) * RT_LD + 16 * s + 8 * hi);
#pragma unroll
        for (int cbk = 0; cbk < 4; ++cbk) {
            const bf16x8 ba = *(const LAS bf16x8*)(Bt + (cbk * 32 + r32) * RT_LD + 16 * s + 8 * hi);
            const bf16x8 bi = *(const LAS bf16x8*)(Bt + (128 + cbk * 32 + r32) * RT_LD + 16 * s + 8 * hi);
            R[cbk] = __builtin_amdgcn_mfma_f32_32x32x16_bf16(af, ba, R[cbk], 0, 0, 0);
            I[cbk] = __builtin_amdgcn_mfma_f32_32x32x16_bf16(af, bi, I[cbk], 0, 0, 0);
        }
    } }
    int ln3 = tid; asm volatile("" : "+v"(ln3)); const int r32 = ln3 & 31, hi = (ln3 >> 5) & 1;
    LAS float* comp = (LAS float*)(lds + RT_COMP); LAS float* hin = (LAS float*)(lds + RT_HIN); LAS float* fold = (LAS float*)(lds + RT_FOLD);
#pragma unroll
    for (int cbk = 0; cbk < 4; ++cbk) {
        const float nba = nba_[cbk], nbi = nbi_[cbk], sp8l = sp8l_[cbk];
        float pc = 1.f, sc = 0.f;
#pragma unroll
        for (int q = 0; q < 4; ++q) {
            float pp = 1.f, ss = 0.f;
#pragma unroll
            for (int e = 0; e < 4; ++e) {
                const int reg = 4 * q + e, srow = wave * 32 + e + 8 * q + 4 * hi;
                const float xc = __uint_as_float(((unsigned)At[srow * RT_LD + cbk * 32 + r32]) << 16);
                const float rg = __builtin_amdgcn_rcpf(1.0f + __builtin_amdgcn_exp2f(fmaf(R[cbk][reg], -1.4426950408889634f, nba)));
                const float ig = __builtin_amdgcn_rcpf(1.0f + __builtin_amdgcn_exp2f(fmaf(I[cbk][reg], -1.4426950408889634f, nbi)));
                const float a = __builtin_amdgcn_exp2f(sp8l * rg);
                const float uu = __builtin_amdgcn_sqrtf(fmaf(-a, a, 1.0f)) * (ig * xc);
                R[cbk][reg] = a; I[cbk][reg] = uu;
                pp *= a; ss = ss * a + uu;
            }
            const auto rp = __builtin_amdgcn_permlane32_swap(__float_as_uint(pp), __float_as_uint(pp), false, false);
            const auto rs = __builtin_amdgcn_permlane32_swap(__float_as_uint(ss), __float_as_uint(ss), false, false);
            sc = sc * __uint_as_float(rp[0]) + __uint_as_float(rs[0]); pc *= __uint_as_float(rp[0]);
            sc = sc * __uint_as_float(rp[1]) + __uint_as_float(rs[1]); pc *= __uint_as_float(rp[1]);
        }
        if (hi == 0) { comp[(wave * 128 + cbk * 32 + r32) * 2] = pc; comp[(wave * 128 + cbk * 32 + r32) * 2 + 1] = sc; }
    }
    unsigned long long* agg = (unsigned long long*)(PP(ws) + WS_AGG);
    unsigned* rfl = (unsigned*)(PP(ws) + WS_RFLAGS) + l * 512;
    __syncthreads();
    if (tid < 128) {
        float pc = 1.f, sc = 0.f;
#pragma unroll
        for (int s = 0; s < 8; ++s) { const float p = comp[(s * 128 + tid) * 2], q = comp[(s * 128 + tid) * 2 + 1]; sc = sc * p + q; pc *= p; }
        __hip_atomic_store(agg + (size_t)rt * 1024 + n * 128 + tid, ((unsigned long long)__float_as_uint(sc) << 32) | __float_as_uint(pc), __ATOMIC_RELAXED, __HIP_MEMORY_SCOPE_AGENT);
    }
    asm volatile("s_waitcnt vmcnt(0)" ::: "memory");
    __syncthreads();
    if (tid == 0) __hip_atomic_store(rfl + rt * 8 + n, 1u, __ATOMIC_RELAXED, __HIP_MEMORY_SCOPE_AGENT);
    if (tid < 32 && b * 32 + tid < rt) { unsigned spins = 0; while (__hip_atomic_load(rfl + (b * 32 + tid) * 8 + n, __ATOMIC_RELAXED, __HIP_MEMORY_SCOPE_AGENT) == 0u && ++spins < (1u << 22)) __builtin_amdgcn_s_sleep(2); }
    __syncthreads();
    {
        const int ch = tid & 127, p = tid >> 7, rbase = b * 32 + 8 * p;
        unsigned long long a2[8];
#pragma unroll
        for (int j = 0; j < 8; ++j) a2[j] = (rbase + j < rt) ? __hip_atomic_load(agg + (size_t)(rbase + j) * 1024 + n * 128 + ch, __ATOMIC_RELAXED, __HIP_MEMORY_SCOPE_AGENT) : 0x000000003f800000ull;
        float pp = 1.f, ss = 0.f;
#pragma unroll
        for (int j = 0; j < 8; ++j) { const float px = __uint_as_float((unsigned)a2[j]), sx = __uint_as_float((unsigned)(a2[j] >> 32)); ss = ss * px + sx; pp *= px; }
        fold[(p * 128 + ch) * 2] = pp; fold[(p * 128 + ch) * 2 + 1] = ss;
    }
    __syncthreads();
    if (tid < 128) {
        float h = 0.f;
#pragma unroll
        for (int p = 0; p < 4; ++p) h = h * fold[(p * 128 + tid) * 2] + fold[(p * 128 + tid) * 2 + 1];
#pragma unroll
        for (int s = 0; s < 8; ++s) { hin[s * 128 + tid] = h; h = h * comp[(s * 128 + tid) * 2] + comp[(s * 128 + tid) * 2 + 1]; }
    }
    __syncthreads();
#pragma unroll
    for (int cbk = 0; cbk < 4; ++cbk) {
        float hs = hin[wave * 128 + cbk * 32 + r32];
#pragma unroll
        for (int q = 0; q < 4; ++q) {
            float pp = 1.f, ss = 0.f, hh;
            float hv[4];
#pragma unroll
            for (int e = 0; e < 4; ++e) { const float a = R[cbk][4 * q + e], uu = I[cbk][4 * q + e]; pp *= a; ss = ss * a + uu; }
            const auto rp = __builtin_amdgcn_permlane32_swap(__float_as_uint(pp), __float_as_uint(pp), false, false);
            const auto rs = __builtin_amdgcn_permlane32_swap(__float_as_uint(ss), __float_as_uint(ss), false, false);
            const float p0 = __uint_as_float(rp[0]), p1 = __uint_as_float(rp[1]), s0 = __uint_as_float(rs[0]), s1 = __uint_as_float(rs[1]);
            const float h_mid = hs * p0 + s0;
            hh = hi ? h_mid : hs;
#pragma unroll
            for (int e = 0; e < 4; ++e) { hh = hh * R[cbk][4 * q + e] + I[cbk][4 * q + e]; hv[e] = hh; }
            hs = h_mid * p1 + s1;
#pragma unroll
            for (int e = 0; e < 4; ++e) { const int srow = wave * 32 + e + 8 * q + 4 * hi; At[srow * RT_LD + cbk * 32 + r32] = (bf16)(pkbf(hv[e], 0.f) & 0xffffu); }
        }
    }
    __syncthreads();
    const float* gs = PP(g_subln) + l * 128;
    const int cg = (tid & 15) * 8;
    const f32x4 g0 = *(const f32x4*)(gs + cg), g1 = *(const f32x4*)(gs + cg + 4);
    const float gsv[8] = {g0[0], g0[1], g0[2], g0[3], g1[0], g1[1], g1[2], g1[3]};
    v4u ovB[8], avB[8], gvB[8];
#pragma unroll
    for (int i = 0; i < 8; ++i) { const int r = (tid >> 4) + 32 * i; const size_t off = (row0 + r) * 1024 + n * 128 + cg;
        ovB[i] = *(const v4u*)(O + off); avB[i] = *(const v4u*)(SGA + off); gvB[i] = *(const v4u*)(G2 + off); }
#pragma unroll
    for (int bt = 0; bt < 2; ++bt) {
#pragma unroll
        for (int i = 0; i < 4; ++i) {
            const v4u ovi = ovB[bt * 4 + i], avi = avB[bt * 4 + i], gvi = gvB[bt * 4 + i];
            const int r = (tid >> 4) + 32 * (bt * 4 + i); const size_t off = (row0 + r) * 1024 + n * 128 + cg;
            const v4u hv = *(const LAS v4u*)(At + r * RT_LD + cg);
            const float o[8] = {bflo(ovi.x), bfhi(ovi.x), bflo(ovi.y), bfhi(ovi.y), bflo(ovi.z), bfhi(ovi.z), bflo(ovi.w), bfhi(ovi.w)};
            float ss = 0.f;
#pragma unroll
            for (int e = 0; e < 8; ++e) ss += o[e] * o[e];
            ss = rowsum16(ss);
            const float rn = __builtin_amdgcn_rsqf(ss * (1.f / 128.f) + 1e-6f) * lam_os;
            const float a[8] = {bflo(avi.x), bfhi(avi.x), bflo(avi.y), bfhi(avi.y), bflo(avi.z), bfhi(avi.z), bflo(avi.w), bfhi(avi.w)};
            const float g[8] = {bflo(gvi.x), bfhi(gvi.x), bflo(gvi.y), bfhi(gvi.y), bflo(gvi.z), bfhi(gvi.z), bflo(gvi.w), bfhi(gvi.w)};
            const float h[8] = {bflo(hv.x), bfhi(hv.x), bflo(hv.y), bfhi(hv.y), bflo(hv.z), bfhi(hv.z), bflo(hv.w), bfhi(hv.w)};
            float m[8];
#pragma unroll
            for (int e = 0; e < 8; ++e) m[e] = a[e] * (o[e] * rn * gsv[e]) + g[e] * h[e];
            v4u w; w.x = pkbf(m[0], m[1]); w.y = pkbf(m[2], m[3]); w.z = pkbf(m[4], m[5]); w.w = pkbf(m[6], m[7]);
            *(v4u*)(MIX + off) = w;
        }
    }
    __syncthreads();
}

__device__ __forceinline__ void act_pass(kaptr_t ka, int l, int b, const bf16* U, bf16* ACT, int gtid, int NT) {
    const float* cw = PP(conv_ffn_w) + (size_t)l * 3 * 6144; const float* cbp = PP(conv_ffn_b) + l * 6144;
    for (int it = gtid; it < 8192 * 384; it += NT) {
        const int t = it / 384, cg = (it % 384) * 8;
        float val[8], gate[8];
        { const f32x4 b0 = *(const f32x4*)(cbp + cg), b1 = *(const f32x4*)(cbp + cg + 4), c0 = *(const f32x4*)(cbp + 3072 + cg), c1 = *(const f32x4*)(cbp + 3072 + cg + 4);
#pragma unroll
          for (int e = 0; e < 4; ++e) { val[e] = b0[e]; val[4 + e] = b1[e]; gate[e] = c0[e]; gate[4 + e] = c1[e]; } }
#pragma unroll
        for (int j = 0; j < 3; ++j) {
            const int ts = t - 2 + j;
            if (ts >= 0) {
                const v4u uv = *(const v4u*)(U + (size_t)ts * 6144 + cg), ug = *(const v4u*)(U + (size_t)ts * 6144 + 3072 + cg);
                const f32x4 w0 = *(const f32x4*)(cw + j * 6144 + cg), w1 = *(const f32x4*)(cw + j * 6144 + cg + 4), x0 = *(const f32x4*)(cw + j * 6144 + 3072 + cg), x1 = *(const f32x4*)(cw + j * 6144 + 3072 + cg + 4);
                val[0] += w0[0] * bflo(uv.x); val[1] += w0[1] * bfhi(uv.x); val[2] += w0[2] * bflo(uv.y); val[3] += w0[3] * bfhi(uv.y);
                val[4] += w1[0] * bflo(uv.z); val[5] += w1[1] * bfhi(uv.z); val[6] += w1[2] * bflo(uv.w); val[7] += w1[3] * bfhi(uv.w);
                gate[0] += x0[0] * bflo(ug.x); gate[1] += x0[1] * bfhi(ug.x); gate[2] += x0[2] * bflo(ug.y); gate[3] += x0[3] * bfhi(ug.y);
                gate[4] += x1[0] * bflo(ug.z); gate[5] += x1[1] * bfhi(ug.z); gate[6] += x1[2] * bflo(ug.w); gate[7] += x1[3] * bfhi(ug.w);
            }
        }
        float r[8];
#pragma unroll
        for (int e = 0; e < 8; ++e) r[e] = pg8::fast_gelu(gate[e]) * val[e];
        v4u w; w.x = pkbf(r[0], r[1]); w.y = pkbf(r[2], r[3]); w.z = pkbf(r[4], r[5]); w.w = pkbf(r[6], r[7]);
        *(v4u*)(ACT + ((size_t)b * 8192 + t) * 3072 + cg) = w;
    }
}

#ifndef STAG_GRP
#define STAG_GRP ((bx >> 3) & 3)
#endif
#ifndef STAG_A
#define STAG_A 0
#endif
#ifndef REP_A
#define REP_A 1
#endif
#ifndef REP_ATT
#define REP_ATT 1
#endif
#ifndef REP_RNN1
#define REP_RNN1 1
#endif
#ifndef REP_D
#define REP_D 1
#endif
#ifndef REP_F
#define REP_F 1
#endif
#ifndef REP_ACT
#define REP_ACT 1
#endif
#ifndef REP_P0
#define REP_P0 1
#endif
constexpr int N_PHASES = 14;
__global__ void __launch_bounds__(NTHREADS, 2) mk_fwd(Params P) {
    extern __shared__ __attribute__((aligned(16))) unsigned char lds_raw[];
    LAS unsigned char* lds = (LAS unsigned char*)lds_raw;
    volatile LAS unsigned* MISC = (volatile LAS unsigned*)(lds + LDS_MISC);
    const int wave0 = __builtin_amdgcn_readfirstlane((int)threadIdx.x >> 6);
#define CUR_TID() cur_tid(wave0)
    const int G = gridDim.x, bx = blockIdx.x, vcu = (G % 8 == 0) ? (bx % 8) * (G / 8) + bx / 8 : bx;
    const int NGW = G * NWAVES;
#define PHASE_IDS() int tid = CUR_TID(); asm volatile("" : "+v"(tid)); const int lane = tid & 63, wave = __builtin_amdgcn_readfirstlane(tid >> 6), gw = vcu * NWAVES + wave; LAS float* scr = (LAS float*)(lds + wave * TR_SCR_BYTES); (void)lane; (void)gw; (void)scr
    const kaptr_t ka = (kaptr_t)__builtin_amdgcn_kernarg_segment_ptr();
    gu32* ctl = (gu32*)PP(ws);
    for (int u = (int)threadIdx.x; u < (LDS_BYTES - LDS_CTL0) / 4; u += NTHREADS) ((LAS unsigned*)(lds + LDS_CTL0))[u] = 0u;
    __syncthreads();
    const int lo = PP(ph_lo), hi = PP(ph_hi);
    const bool multi = (hi - lo) > 1;
    XcdBarrier bar; bar.bar = (unsigned*)(ctl + CW_BAR); bar.x = 0; bar.st = nullptr;
    if (multi) bar = xcd_barrier_post((unsigned*)(ctl + CW_BAR), MISC + 8);
#define IN(k) (lo <= (k) && (k) < hi)
#define SEAM(k) do { if (IN(k) && IN((k) + 1)) xcd_barrier(bar); } while (0)

#define WS_PTRS() unsigned char* ws = PP(ws); \
    float* mod = (float*)(ws + WS_MOD); float* lamv = (float*)(ws + WS_LAM); float* cs = (float*)(ws + WS_COS); float* sn = (float*)(ws + WS_SIN); \
    bf16* S1 = (bf16*)(ws + 1 * SLOT); bf16* S2 = (bf16*)(ws + 2 * SLOT); bf16* S5 = (bf16*)(ws + 5 * SLOT); bf16* S6 = (bf16*)(ws + 6 * SLOT); bf16* S7 = (bf16*)(ws + 7 * SLOT); \
    bf16* WA = (bf16*)(ws + WS_WA); bf16* WOUT = (bf16*)(ws + WS_WOUT); bf16* WDOWN = (bf16*)(ws + WS_WDOWN); \
    float* rss0 = (float*)(ws + WS_RSS0); float* bias_in = (float*)(ws + WS_BIASIN); float* bias_up = (float*)(ws + WS_BIASUP); \
    const float* md = mod + (size_t)l * 2 * 6144; float* rssA = (float*)(ws + WS_RSS) + (size_t)(l * 2 + 0) * M; float* rssB = (float*)(ws + WS_RSS) + (size_t)(l * 2 + 1) * M; \
    const float* rss_in = l == 0 ? rss0 : (float*)(ws + WS_RSS) + (size_t)1 * M; bf16* RES = (bf16*)PP(out); bf16* S4 = (bf16*)(ws + 4 * SLOT);   \
    (void)mod; (void)lamv; (void)cs; (void)sn; (void)S1; (void)S2; (void)S5; (void)S6; (void)S7; (void)WA; (void)WOUT; (void)WDOWN; (void)rss0; (void)bias_in; (void)bias_up; (void)md; (void)rssA; (void)rssB; (void)rss_in; (void)RES; (void)S4

    if (IN(0)) {
        PHASE_IDS(); const int l = 0; WS_PTRS();
        for (int task = gw; task < 1536; task += NGW) {
            const int l = task / 768, rem = task % 768, chunk = rem >> 3, ks = rem & 7, n = chunk * 64 + lane;
            const float* w = PP(w_mod) + (size_t)l * 1024 * 6144 + (size_t)(ks * 128) * 6144 + n;
            float a0 = 0.f, a1 = 0.f;
            float sl[2][2];
#pragma unroll
            for (int bb = 0; bb < 2; ++bb)
#pragma unroll
                for (int hh = 0; hh < 2; ++hh) { const float cv = PP(c)[bb * 1024 + ks * 128 + hh * 64 + lane]; sl[bb][hh] = cv * __builtin_amdgcn_rcpf(1.f + __expf(-cv)); }
#pragma unroll
            for (int hh = 0; hh < 2; ++hh) {
#pragma unroll
                for (int k = 0; k < 64; ++k) { const float wv = w[(size_t)(hh * 64 + k) * 6144];
                    a0 += __builtin_bit_cast(float, __builtin_amdgcn_readlane(__builtin_bit_cast(int, sl[0][hh]), k)) * wv; a1 += __builtin_bit_cast(float, __builtin_amdgcn_readlane(__builtin_bit_cast(int, sl[1][hh]), k)) * wv; }
            }
            if (ks == 0) { const float bm = PP(b_mod)[l * 6144 + n]; a0 += bm; a1 += bm; }
            atomicAdd(mod + (size_t)(l * 2 + 0) * 6144 + n, a0); atomicAdd(mod + (size_t)(l * 2 + 1) * 6144 + n, a1);
        }
        if (gw == 0 && lane < 2) {
            const int l = lane; float s1 = 0.f, s2 = 0.f;
            for (int i = 0; i < 64; ++i) { s1 += PP(lq1)[l * 64 + i] * PP(lk1)[l * 64 + i]; s2 += PP(lq2)[l * 64 + i] * PP(lk2)[l * 64 + i]; }
            lamv[l] = expf(s1) - expf(s2) + (0.8f - 0.6f * expf(-0.3f * (float)l));
        }
        for (int idx = gw * 64 + lane; idx < M * 32; idx += NGW * 64) {
            const int row = idx >> 5, i = idx & 31;
            const float inv = (float)exp(-(double)i * (9.210340371976184 / 32.0));
            const float ang = (float)PP(pos)[row] * inv;
            const double a = (double)ang, k = rint(a * 0.15915494309189535);
            const float rf = (float)(fma(-k, 6.283185307179586, a) - k * 2.4492935982947064e-16);
            cs[idx] = __cosf(rf); sn[idx] = __sinf(rf);
        }
        int base = 0;
        base = convert_w<1>(PP(w_in), 1024, NIN, NIN, WA, scr, gw, NGW, base, lane);
        base = convert_w<0>(PP(w_out), 1024, 1024, 1024, WOUT, scr, gw, NGW, base, lane);
        base = convert_w<0>(PP(w_down), 3072, 1024, 1024, WDOWN, scr, gw, NGW, base, lane);
        for (int nb = 0; nb < 8; ++nb) {
            base = convert_w<0>(PP(w_rg_a) + (size_t)nb * 16384, 128, 128, 128, (bf16*)(ws + WS_RGA) + (size_t)nb * 16384, scr, gw, NGW, base, lane);
            base = convert_w<0>(PP(w_rg_i) + (size_t)nb * 16384, 128, 128, 128, (bf16*)(ws + WS_RGI) + (size_t)nb * 16384, scr, gw, NGW, base, lane);
        }
    }
    SEAM(0);
    if (IN(1)) {
        PHASE_IDS(); const int l = 0; WS_PTRS();
        const float* g = PP(g_mix);
        for (int row0 = gw; row0 < M; row0 += 4 * NGW) {
            f32x4 v[4][4];
#pragma unroll
            for (int q = 0; q < 4; ++q) { const f32x4* xr = (const f32x4*)(PP(x) + (size_t)(row0 + q * NGW) * 1024) + lane;
#pragma unroll
                for (int j = 0; j < 4; ++j) v[q][j] = xr[64 * j]; }
#pragma unroll
            for (int q = 0; q < 4; ++q) {
                const int row = row0 + q * NGW, b = row >> 13; const float* sc = mod + (size_t)b * 6144 + 1024;
                float s = 0.f;
#pragma unroll
                for (int j = 0; j < 4; ++j) s += (v[q][j][0] * v[q][j][0] + v[q][j][1] * v[q][j][1]) + (v[q][j][2] * v[q][j][2] + v[q][j][3] * v[q][j][3]);
                s = wsum64(s);
                if (lane == 0) rss0[row] = s;
#pragma unroll
                for (int j = 0; j < 4; ++j) { const int k = (lane + 64 * j) * 4; const f32x4 gm = *(const f32x4*)(g + k) * (*(const f32x4*)(sc + k) + 1.0f); const f32x4 a = v[q][j] * gm;
                    v2u w; w.x = pkbf(a[0], a[1]); w.y = pkbf(a[2], a[3]); *(v2u*)(S1 + (size_t)row * 1024 + k) = w; }
            }
        }
        bias_rows(WA, NIN, mod + 0, mod + 6144, bias_in, 7168, gw, NGW, lane);
    }
    SEAM(1);

    for (int l = 0; l < 2; ++l) {
        const int pb = 2 + 6 * l;
        if (IN(pb + 0)) {
            WS_PTRS();
            pg8::Gemm g{S1, WA, M, NIN, 1024}; pg8::StaticOrder S; S.init(M, NIN, G, bx);
            pg8::EpiIn E{S2, cs, sn, rss_in, bias_in};
#if STAG_A > 0
            { const int grp = STAG_GRP; if (grp) { const unsigned long long t0 = __builtin_amdgcn_s_memrealtime(); while (__builtin_amdgcn_s_memrealtime() - t0 < (unsigned long long)(grp * STAG_A)) __builtin_amdgcn_s_sleep(8); } }
#endif
            for (int rep = 0; rep < REP_A; ++rep) pg8::gemm_phase<pg8::EpiIn, pg8::StaticOrder, true, true>(lds, g, S, E, CUR_TID());
        }
        SEAM(pb + 0);
        if (IN(pb + 1)) {
            PHASE_IDS(); WS_PTRS();
            if (G == 256) {
#pragma unroll 1
                for (int i = 0; i < 4 * REP_ATT; ++i) {
                    const int bh = vcu >> 4, b = bh >> 3, h = bh & 7, s = vcu & 15;
                    const int qb = (i & 2) ? s : 31 - s, c = i & 1, hm = 2 * h + c;
                    const float lam = c ? lamv[l] : 0.f;
                    const attn_body::bf16* sb = (const attn_body::bf16*)(ws + SLOT);
                    constexpr size_t SE = SLOT / 2;
                    attn_body::attn_unit<8>(b, 0, qb, sb + SE + hm * 64, sb + 2 * SE + hm * 64, sb + 3 * SE + h * 128, (attn_body::bf16*)sb + h * 128, (char*)lds_raw, c == 1, lam, CUR_TID());
                }
            }
        }
        SEAM(pb + 1);
        if (IN(pb + 2)) {
            PHASE_IDS(); WS_PTRS();
            const float lam_os = 1.0f - (0.8f - 0.6f * expf(-0.3f * (float)l));
            rnn_stage_w(ka, vcu & 7, lds, tid);
            for (int rep = 0; rep < REP_D; ++rep) for (int t = vcu; t < 512; t += G) rnn_tile<true>(ka, l, t >> 3, t & 7, lds, tid, wave, lane, S5, S1, S6, S7, S2, lam_os);
            { int t2_ = CUR_TID(); asm volatile("" : "+v"(t2_)); const int lane_ = t2_ & 63, wave_ = __builtin_amdgcn_readfirstlane(t2_ >> 6), gw_ = vcu * NWAVES + wave_; LAS float* scr_ = (LAS float*)(lds + wave_ * TR_SCR_BYTES);
              bf16* S3 = (bf16*)(ws + 3 * SLOT);
              int base = 0;
              base = convert_w<2>(PP(w_up) + (size_t)l * 1024 * NUP, 1024, NUP, NUP, S3, scr_, gw_, NGW, base, lane_);
              if (l == 0) base = convert_w<1>(PP(w_in) + (size_t)1024 * NIN, 1024, NIN, NIN, WA, scr_, gw_, NGW, base, lane_);
              if (l == 1) base = convert_w<0>(PP(w_down) + (size_t)3072 * 1024, 3072, 1024, 1024, WDOWN, scr_, gw_, NGW, base, lane_); }
        }
        SEAM(pb + 2);
        if (IN(pb + 3)) {
            PHASE_IDS(); WS_PTRS();
            { pg8::Gemm g{S2, WOUT, M, 1024, 1024}; pg8::StaticOrder S; S.init(M, 1024, G, bx);
              pg8::EpiRes E{l == 0 ? PP(x) : (const float*)nullptr, RES, l == 0 ? RES : S4, md + 2048, PP(g_ffn) + l * 1024, md + 4096, S1, rssA};
              pg8::gemm_phase<pg8::EpiRes, pg8::StaticOrder, true, true>(lds, g, S, E, CUR_TID()); }
            { int t2_ = CUR_TID(); asm volatile("" : "+v"(t2_)); const int lane_ = t2_ & 63, gw_ = vcu * NWAVES + __builtin_amdgcn_readfirstlane(t2_ >> 6);
              bias_rows((const bf16*)(ws + 3 * SLOT), NUP, md + 3072, md + 6144 + 3072, bias_up, 6144, gw_, NGW, lane_);
              if (l == 0) bias_rows(WA, NIN, mod + 2 * 6144, mod + 3 * 6144, bias_in, 7168, gw_, NGW, lane_); }
        }
        SEAM(pb + 3);
        if (IN(pb + 4)) {
            WS_PTRS();
            { pg8::Gemm g{S1, (const bf16*)(ws + 3 * SLOT), M, NUP, 1024}; pg8::StaticOrder S; S.init(M, NUP, G, bx);
              pg8::EpiUpConv E{S5, rssA, bias_up, PP(conv_ffn_w) + (size_t)l * 3 * NUP, PP(conv_ffn_b) + l * NUP, (float*)S2, (unsigned*)(ws + WS_FLAGS) + l * 1536, (PG8_LAS float*)(lds + 131072)};
#ifdef STAG_F
              { const int grp = (bx >> 6); if (grp) { const unsigned long long t0 = __builtin_amdgcn_s_memrealtime(); while (__builtin_amdgcn_s_memrealtime() - t0 < (unsigned long long)(grp * STAG_F)) __builtin_amdgcn_s_sleep(8); } }
#endif
              for (int rep = 0; rep < REP_F; ++rep) pg8::gemm_phase<pg8::EpiUpConv, pg8::StaticOrder, true, true>(lds, g, S, E, CUR_TID()); }
            if (l == 0) { int t2_ = CUR_TID(); asm volatile("" : "+v"(t2_)); const int lane_ = t2_ & 63, wave_ = __builtin_amdgcn_readfirstlane(t2_ >> 6), gw_ = vcu * NWAVES + wave_; LAS float* scr_ = (LAS float*)(lds + wave_ * TR_SCR_BYTES);
                int base = 0;
                base = convert_w<0>(PP(w_out) + (size_t)1024 * 1024, 1024, 1024, 1024, WOUT, scr_, gw_, NGW, base, lane_);
                for (int nb = 0; nb < 8; ++nb) {
                    base = convert_w<0>(PP(w_rg_a) + (size_t)(8 + nb) * 16384, 128, 128, 128, (bf16*)(ws + WS_RGA) + (size_t)nb * 16384, scr_, gw_, NGW, base, lane_);
                    base = convert_w<0>(PP(w_rg_i) + (size_t)(8 + nb) * 16384, 128, 128, 128, (bf16*)(ws + WS_RGI) + (size_t)nb * 16384, scr_, gw_, NGW, base, lane_);
                }
            }
        }
        SEAM(pb + 4);
        if (IN(pb + 5)) {
            PHASE_IDS(); WS_PTRS();
            if (l == 0) { pg8::Gemm g{S5, WDOWN, M, 1024, 3072}; pg8::StaticOrder S; S.init(M, 1024, G, bx);
              pg8::EpiRes E{(const float*)nullptr, RES, RES, md + 5120, PP(g_mix) + 1024, mod + 2 * 6144 + 1024, S1, rssB};
              pg8::gemm_phase<pg8::EpiRes, pg8::StaticOrder, true, true>(lds, g, S, E, CUR_TID()); }
            else { pg8::Gemm g{S5, WDOWN, M, 1024, 3072}; pg8::StaticOrder S; S.init(M, 1024, G, bx);
              pg8::EpiFinal E{S4, PP(out), md + 5120, PP(g_final), rssB, (unsigned*)(ws + WS_FCNT)};
              pg8::gemm_phase<pg8::EpiFinal, pg8::StaticOrder, true, true>(lds, g, S, E, CUR_TID()); }
        }
        SEAM(pb + 5);
    }
#undef IN
#undef SEAM
}

#ifndef MK_ONE_LAUNCH
#define MK_ONE_LAUNCH 1
#endif
extern "C" void kernel_launch(void* const* d_in, const int* in_sizes, int n_in, void* d_out, int out_size, void* d_ws, size_t ws_size, hipStream_t stream) {
    static int grid = 0;
    if (grid == 0) {
        int dev = 0, cus = 0;
        (void)hipGetDevice(&dev); (void)hipDeviceGetAttribute(&cus, hipDeviceAttributeMultiprocessorCount, dev);
        if (hipFuncSetAttribute((const void*)mk_fwd, hipFuncAttributeMaxDynamicSharedMemorySize, LDS_BYTES) != hipSuccess) { fprintf(stderr, "kernel_launch: hipFuncSetAttribute failed\n"); grid = -1; return; }
        grid = 256;
        if (cus != 256) fprintf(stderr, "kernel_launch: %d CUs reported; this kernel is built for 256\n", cus);
        if (ws_size < 8 * SLOT) { fprintf(stderr, "kernel_launch: workspace too small (%zu)\n", ws_size); grid = -1; return; }
    }
    if (grid < 0) return;
    (void)hipMemsetAsync(d_ws, 0, WS_CTLZERO, stream);
    Params p{};
    p.x = (const float*)d_in[0]; p.c = (const float*)d_in[1]; p.pos = (const int*)d_in[2];
    p.w_mod = (const float*)d_in[3]; p.b_mod = (const float*)d_in[4]; p.g_mix = (const float*)d_in[5]; p.w_in = (const float*)d_in[6];
    p.lq1 = (const float*)d_in[7]; p.lk1 = (const float*)d_in[8]; p.lq2 = (const float*)d_in[9]; p.lk2 = (const float*)d_in[10]; p.g_subln = (const float*)d_in[11];
    p.conv_rnn_w = (const float*)d_in[12]; p.conv_rnn_b = (const float*)d_in[13]; p.w_rg_a = (const float*)d_in[14]; p.b_rg_a = (const float*)d_in[15];
    p.w_rg_i = (const float*)d_in[16]; p.b_rg_i = (const float*)d_in[17]; p.lam_rg = (const float*)d_in[18]; p.w_out = (const float*)d_in[19]; p.g_ffn = (const float*)d_in[20];
    p.w_up = (const float*)d_in[21]; p.conv_ffn_w = (const float*)d_in[22]; p.conv_ffn_b = (const float*)d_in[23]; p.w_down = (const float*)d_in[24]; p.g_final = (const float*)d_in[25];
    p.out = (float*)d_out; p.ws = (unsigned char*)d_ws;
#if MK_ONE_LAUNCH
    p.ph_lo = 0; p.ph_hi = N_PHASES;
    hipLaunchKernelGGL(mk_fwd, dim3(grid), dim3(NTHREADS), LDS_BYTES, stream, p);
#else
    for (int ph = 0; ph < N_PHASES; ++ph) { p.ph_lo = ph; p.ph_hi = ph + 1; hipLaunchKernelGGL(mk_fwd, dim3(grid), dim3(NTHREADS), LDS_BYTES, stream, p); }
#endif
}
```
